# Optimizing an MI355X kernel written in HIP

```python
import jax, jax.numpy as jnp
from jax import lax
import numpy as np

D_MODEL = 2048
BATCH = 4
SEQ = 2048
DEPTH = 2
DEC_BATCH = 128
DEC_SEQ = 8
PAST_LEN = 16384
PAGE_SIZE = 128

N_MIXERS = 2
N_A = (DEPTH + 1) // 2
N_B = DEPTH // 2
HG_HEADS = 16
HG_DK = 128
HG_DV = D_MODEL // HG_HEADS
HG_FDIM = HG_HEADS * HG_DK
HG_CHUNK = 16
POOL_WINDOWS = (2, 4, 8, 16)
POOL_GROUPS = len(POOL_WINDOWS)
POOL_GC = D_MODEL // POOL_GROUPS
POOL_BUF = max(POOL_WINDOWS) - 1
N_MEM = 256
MEM_HEADS = 4
MEM_HD = D_MODEL // MEM_HEADS
D_FF = 4 * D_MODEL
EPS = 1e-6

kernel_name = "hgrn2_pool_hybrid_decode_step"


def rms_norm(x, w):
    xf = x.astype(jnp.float32)
    y = xf * lax.rsqrt(jnp.mean(xf * xf, axis=-1, keepdims=True) + EPS)
    return (y * w.astype(jnp.float32)).astype(x.dtype)


def lower_bounds(lb_logits):
    sm = jax.nn.softmax(lb_logits.astype(jnp.float32), axis=0)
    return jnp.cumsum(sm, axis=0)


def chunk_gla(q, k, v, logf, S0):
    B, L, H, DK = q.shape
    DV = v.shape[-1]
    C = HG_CHUNK if L % HG_CHUNK == 0 else L
    n = L // C

    def blocks(a):
        return a.reshape(B, n, C, H, a.shape[-1]).swapaxes(0, 1)

    causal = jnp.tril(jnp.ones((C, C), dtype=bool))

    def step(S, inp):
        qc, kc, vc, gc = inp
        b = jnp.cumsum(gc, axis=1)
        b_last = b[:, -1]
        q_dec = qc * jnp.exp(b)
        k_inv = kc * jnp.exp(-b)
        A = jnp.einsum('bthk,bshk->bhts', q_dec, k_inv)
        A = jnp.where(causal, A, 0.0)
        o = jnp.einsum('bhts,bshv->bthv', A, vc) + jnp.einsum('bthk,bhkv->bthv', q_dec, S)
        k_end = kc * jnp.exp(b_last[:, None] - b)
        S = S * jnp.exp(b_last)[..., None] + jnp.einsum('bshk,bshv->bhkv', k_end, vc)
        return S, o

    S, o = lax.scan(step, S0, (blocks(q), blocks(k), blocks(v), blocks(logf)))
    return o.swapaxes(0, 1).reshape(B, L, H, DV), S


def hgrn2_mixer(h, S0, w_in, lb, norm_w, w_out):
    B, L, _ = h.shape
    proj = h @ w_in
    q = proj[..., :HG_FDIM]
    fl = proj[..., HG_FDIM:2 * HG_FDIM]
    i = proj[..., 2 * HG_FDIM:2 * HG_FDIM + D_MODEL]
    g = proj[..., 2 * HG_FDIM + D_MODEL:]
    q = jax.nn.silu(q.astype(jnp.float32)).reshape(B, L, HG_HEADS, HG_DK)
    f = lb + (1.0 - lb) * jax.nn.sigmoid(fl.astype(jnp.float32))
    f = f.reshape(B, L, HG_HEADS, HG_DK)
    k = 1.0 - f
    v = i.astype(jnp.float32).reshape(B, L, HG_HEADS, HG_DV)
    o, S = chunk_gla(q, k, v, jnp.log(f), S0.astype(jnp.float32))
    o = o * lax.rsqrt(jnp.mean(o * o, axis=-1, keepdims=True) + EPS) * norm_w.astype(jnp.float32)
    o = o * jax.nn.silu(g.astype(jnp.float32).reshape(B, L, HG_HEADS, HG_DV))
    return o.reshape(B, L, D_MODEL).astype(h.dtype) @ w_out, S


def pool_mixer(h, buf, pos0, w_in, pool_w, pool_scale, w_out):
    B, L, _ = h.shape
    u = h @ w_in
    ext = jnp.concatenate([buf.astype(u.dtype), u], axis=1)
    cs = jnp.cumsum(ext.astype(jnp.float32), axis=1)
    cs = jnp.concatenate([jnp.zeros((B, 1, D_MODEL), jnp.float32), cs], axis=1)
    pos = pos0 + jnp.arange(L)
    end = cs[:, POOL_BUF + 1:POOL_BUF + 1 + L]
    means = []
    for gi, w in enumerate(POOL_WINDOWS):
        sl = slice(gi * POOL_GC, (gi + 1) * POOL_GC)
        start = cs[:, POOL_BUF + 1 - w:POOL_BUF + 1 - w + L, sl]
        cnt = jnp.minimum(w, pos + 1).astype(jnp.float32)
        means.append((end[..., sl] - start) / cnt[None, :, None])
    pooled = jnp.concatenate(means, axis=-1) - u.astype(jnp.float32)
    pooled = pooled.reshape(B, L, POOL_GROUPS, POOL_GC)
    mixed = jnp.einsum('blgc,gcd->blgd', pooled, pool_w.astype(jnp.float32)).reshape(B, L, D_MODEL)
    mixed = (mixed * pool_scale.astype(jnp.float32)).astype(h.dtype)
    return mixed @ w_out, ext[:, -POOL_BUF:]


def mem_kv(mem, norm_mem, w_xkv):
    B = mem.shape[0]
    kv = rms_norm(mem, norm_mem) @ w_xkv
    k = kv[..., :D_MODEL].reshape(B, N_MEM, MEM_HEADS, MEM_HD)
    v = kv[..., D_MODEL:].reshape(B, N_MEM, MEM_HEADS, MEM_HD)
    return k, v


def mem_cross_attn(h, k, v, w_xq, w_xo):
    B, L, _ = h.shape
    q = (h @ w_xq).reshape(B, L, MEM_HEADS, MEM_HD).astype(jnp.float32)
    s = jnp.einsum('blhd,bmhd->bhlm', q, k.astype(jnp.float32)) * (MEM_HD ** -0.5)
    p = jax.nn.softmax(s, axis=-1)
    o = jnp.einsum('bhlm,bmhd->blhd', p, v.astype(jnp.float32))
    return o.reshape(B, L, D_MODEL).astype(h.dtype) @ w_xo


def trunk(x, pos0, S_in, buf_in, mk, mv, p):
    lbs = lower_bounds(p['hg_lb_logits'])
    S_out, buf_out = [], []
    for l in range(DEPTH):
        j = l // N_MIXERS
        hn = rms_norm(x, p['norm_mix_pre'][l])
        if l % N_MIXERS == 0:
            m, S = hgrn2_mixer(hn, S_in[j], p['w_in_a'][j], lbs[l], p['hg_norm'][j], p['w_out_a'][j])
            S_out.append(S)
        else:
            m, b = pool_mixer(hn, buf_in[j], pos0, p['w_in_b'][j], p['pool_w'][j],
                              p['pool_scale'][j], p['w_out_b'][j])
            buf_out.append(b)
        x = x + rms_norm(m, p['norm_mix_post'][l])
        hn = rms_norm(x, p['norm_x_pre'][l])
        a = mem_cross_attn(hn, mk[l], mv[l], p['w_xq'][l], p['w_xo'][l])
        x = x + rms_norm(a, p['norm_x_post'][l])
        hn = rms_norm(x, p['norm_mlp_pre'][l])
        f = jnp.square(jax.nn.relu(hn @ p['w_up'][l])) @ p['w_down'][l]
        x = x + rms_norm(f, p['norm_mlp_post'][l])
    return x, jnp.stack(S_out), jnp.stack(buf_out)


def setup_inputs(seed: int = 0) -> dict:
    key = jax.random.key(seed)
    ks = jax.random.split(key, 32)
    f32 = jnp.float32

    def nrm(k, shape, scale):
        return scale * jax.random.normal(k, shape, f32)

    def gain(k, shape):
        return 1.0 + 0.05 * jax.random.normal(k, shape, f32)

    sD = D_MODEL ** -0.5
    return {
        "x_prompt": nrm(ks[0], (BATCH, SEQ, D_MODEL), 1.0),
        "x_sample": nrm(ks[1], (DEC_BATCH, DEC_SEQ, D_MODEL), 1.0),
        "state_hgrn": nrm(ks[2], (N_A, DEC_BATCH, HG_HEADS, HG_DK, HG_DV), 0.5),
        "state_pool": nrm(ks[3], (N_B, DEC_BATCH, POOL_BUF, D_MODEL), 1.0),
        "cache_mem_k": nrm(ks[4], (DEPTH, DEC_BATCH, N_MEM, MEM_HEADS, MEM_HD), 1.0),
        "cache_mem_v": nrm(ks[5], (DEPTH, DEC_BATCH, N_MEM, MEM_HEADS, MEM_HD), 1.0),
        "mem_prompt": nrm(ks[6], (BATCH, N_MEM, D_MODEL), 1.0),
        "w_in_a": nrm(ks[7], (N_A, D_MODEL, 2 * HG_FDIM + 2 * D_MODEL), sD),
        "hg_lb_logits": nrm(ks[8], (DEPTH + 1, HG_FDIM), 0.1),
        "hg_norm": gain(ks[9], (N_A, HG_DV)),
        "w_out_a": nrm(ks[10], (N_A, D_MODEL, D_MODEL), sD),
        "w_in_b": nrm(ks[11], (N_B, D_MODEL, D_MODEL), sD),
        "pool_w": nrm(ks[12], (N_B, POOL_GROUPS, POOL_GC, POOL_GC), POOL_GC ** -0.5),
        "pool_scale": 1.0 + 0.1 * jax.random.normal(ks[13], (N_B, D_MODEL), f32),
        "w_out_b": nrm(ks[14], (N_B, D_MODEL, D_MODEL), sD),
        "norm_mem": gain(ks[15], (DEPTH, D_MODEL)),
        "w_xq": nrm(ks[16], (DEPTH, D_MODEL, D_MODEL), sD),
        "w_xkv": nrm(ks[17], (DEPTH, D_MODEL, 2 * D_MODEL), sD),
        "w_xo": nrm(ks[18], (DEPTH, D_MODEL, D_MODEL), sD),
        "norm_mix_pre": gain(ks[19], (DEPTH, D_MODEL)),
        "norm_mix_post": gain(ks[20], (DEPTH, D_MODEL)),
        "norm_x_pre": gain(ks[21], (DEPTH, D_MODEL)),
        "norm_x_post": gain(ks[22], (DEPTH, D_MODEL)),
        "norm_mlp_pre": gain(ks[23], (DEPTH, D_MODEL)),
        "norm_mlp_post": gain(ks[24], (DEPTH, D_MODEL)),
        "w_up": nrm(ks[25], (DEPTH, D_MODEL, D_FF), sD),
        "w_down": nrm(ks[26], (DEPTH, D_FF, D_MODEL), D_FF ** -0.5),
    }


def reference(x_prompt, x_sample, state_hgrn, state_pool, cache_mem_k, cache_mem_v, mem_prompt,
              w_in_a, hg_lb_logits, hg_norm, w_out_a, w_in_b, pool_w, pool_scale, w_out_b,
              norm_mem, w_xq, w_xkv, w_xo, norm_mix_pre, norm_mix_post, norm_x_pre, norm_x_post,
              norm_mlp_pre, norm_mlp_post, w_up, w_down):
    p = dict(w_in_a=w_in_a, hg_lb_logits=hg_lb_logits, hg_norm=hg_norm, w_out_a=w_out_a,
             w_in_b=w_in_b, pool_w=pool_w, pool_scale=pool_scale, w_out_b=w_out_b,
             w_xq=w_xq, w_xo=w_xo, norm_mix_pre=norm_mix_pre, norm_mix_post=norm_mix_post,
             norm_x_pre=norm_x_pre, norm_x_post=norm_x_post, norm_mlp_pre=norm_mlp_pre,
             norm_mlp_post=norm_mlp_post, w_up=w_up, w_down=w_down)
    mk_list, mv_list = [], []
    for l in range(DEPTH):
        k, v = mem_kv(mem_prompt, norm_mem[l], w_xkv[l])
        mk_list.append(k)
        mv_list.append(v)
    cache_mem_k_prompt = jnp.stack(mk_list)
    cache_mem_v_prompt = jnp.stack(mv_list)
    S0 = jnp.zeros((N_A, BATCH, HG_HEADS, HG_DK, HG_DV), jnp.float32)
    buf0 = jnp.zeros((N_B, BATCH, POOL_BUF, D_MODEL), x_prompt.dtype)
    y_prompt, state_hgrn_prompt, state_pool_prompt = trunk(
        x_prompt, 0, S0, buf0, cache_mem_k_prompt, cache_mem_v_prompt, p)
    y_sample, state_hgrn_sample, state_pool_sample = trunk(
        x_sample, PAST_LEN, state_hgrn, state_pool, cache_mem_k, cache_mem_v, p)
    return (y_prompt, y_sample, state_hgrn_prompt, state_pool_prompt, cache_mem_k_prompt,
            cache_mem_v_prompt, state_hgrn_sample, state_pool_sample)
```

```cpp
#include <hip/hip_runtime.h>
#include <cstdio>
#include <cstdint>

#ifndef MK_SPLIT
#define MK_SPLIT 0
#endif
#ifndef MK_LAST_PHASE
#define MK_LAST_PHASE 25
#endif

#define BRINGUP_SCALE 1.0f
#ifndef PROBE_ATT
#define PROBE_ATT 1
#endif
#ifndef PROBE_P0
#define PROBE_P0 1
#endif
#ifndef PROBE_G1
#define PROBE_G1 1
#endif
#ifndef PROBE_GLA
#define PROBE_GLA 1
#endif
#define GAS __attribute__((address_space(1)))
#define LAS __attribute__((address_space(3)))
typedef unsigned short bf16;
typedef unsigned v4u __attribute__((ext_vector_type(4)));
typedef unsigned v2u __attribute__((ext_vector_type(2)));
typedef float f32x4 __attribute__((ext_vector_type(4)));
typedef float f32x2 __attribute__((ext_vector_type(2)));
typedef short bf16x8 __attribute__((ext_vector_type(8)));
typedef short bf16x4 __attribute__((ext_vector_type(4)));

constexpr int D = 2048, FF = 8192, NPROJ = 8192;
constexpr int TP = 8192, TS = 1024, MT = 9216;
constexpr int SEQ = 2048, NB = 4, DB = 128, DSQ = 8;
constexpr int NMEM = 256, MH = 4, MHD = 512;
constexpr int HH = 16, DK = 128, DV = 128;
constexpr int NCHUNK = 640;
constexpr float EPS = 1e-6f;
constexpr int NWAVES = 8, NTHR = 512;

constexpr size_t O_Y = 0, O_SHP = 18874368, O_SPP = 19922944, O_KP = 20045824, O_VP = 24240128, O_SHS = 28434432, O_SPS = 61988864, O_END = 65921024;

constexpr size_t MiB = 1u << 20;
constexpr size_t WS_CTL = 0, CTL_ZERO_BYTES = 1 * MiB;
constexpr size_t WS_WINA = 2 * MiB, WS_WOUTA = 34 * MiB, WS_WINB = 42 * MiB, WS_WPOOL = 50 * MiB, WS_WOUTB = 52 * MiB, WS_WXQ = 60 * MiB, WS_WXO = 76 * MiB,
                 WS_WXKV = 92 * MiB, WS_WUP = 124 * MiB, WS_WDOWN = 188 * MiB;
constexpr size_t WS_HN = 256 * MiB;
constexpr size_t WS_MEMN = 292 * MiB;
constexpr size_t WS_KPB = 300 * MiB;
constexpr size_t WS_VPT = 308 * MiB;
constexpr size_t WS_PROJ = 320 * MiB;
constexpr size_t WS_H = 320 * MiB;
constexpr size_t WS_QD = 608 * MiB, WS_KI = 648 * MiB, WS_KET = 688 * MiB, WS_VT = 728 * MiB, WS_DEC = 768 * MiB;
constexpr size_t WS_M = 776 * MiB;
constexpr size_t WS_Q = 848 * MiB;
constexpr size_t WS_AO = 884 * MiB;
constexpr size_t WS_OG = 920 * MiB;
constexpr size_t WS_POOLED = 956 * MiB;
constexpr size_t WS_MIXED = 992 * MiB;
constexpr size_t WS_U = 1028 * MiB;
constexpr size_t WS_P = 1100 * MiB;
constexpr size_t WS_QS = 320 * MiB, WS_VI = 356 * MiB, WS_GS = 392 * MiB, WS_FL = 428 * MiB;
constexpr size_t WS_REC = 1116 * MiB;
constexpr size_t WS_SEND = 1336 * MiB;
constexpr size_t WS_DSEG = 1348 * MiB;
constexpr size_t WS_SLAB = 1352 * MiB;
constexpr size_t WS_VPB = 1416 * MiB;
constexpr size_t WS_VWT = 1424 * MiB;
constexpr size_t WS_XB = 1440 * MiB;
constexpr size_t WS_RS = 1476 * MiB;
constexpr size_t WS_WXQN = 1477 * MiB;
constexpr size_t WS_WKT1 = 256 * MiB;
constexpr size_t WS_WKT = 1493 * MiB;
constexpr size_t WS_END = 1509 * MiB;
constexpr int REC_BYTES = 18432, REC_DEC = 0, REC_KET = 1024, REC_VT = 5120, REC_KI = 9216, REC_QD = 13568, REC_ROW = 272;
constexpr int SLOT_BYTES = 22528, SLOT_GS = 18432;
constexpr int CW_FLAG = 16384;
constexpr int CW_BAR = 4096;

constexpr int RING_BYTES = 131072;
constexpr int LDS_BYTES = 147456;
constexpr int MISC_OFF = LDS_BYTES - 256;

#define LDS_WAIT() asm volatile("s_waitcnt lgkmcnt(0)" ::: "memory")
#define VM_WAIT() asm volatile("s_waitcnt vmcnt(0)" ::: "memory")
__device__ __forceinline__ unsigned cvt_pk_bf16(float lo, float hi) { unsigned r; asm volatile("v_cvt_pk_bf16_f32 %0, %1, %2" : "=v"(r) : "v"(lo), "v"(hi)); return r; }
__device__ __forceinline__ float bf_lo(unsigned w) { return __uint_as_float(w << 16); }
__device__ __forceinline__ float bf_hi(unsigned w) { return __uint_as_float(w & 0xffff0000u); }
__device__ __forceinline__ int lane_id() { int l; asm volatile("v_mbcnt_lo_u32_b32 %0, -1, 0\n\tv_mbcnt_hi_u32_b32 %0, -1, %0" : "=v"(l)); return l; }
template <class T> __device__ __forceinline__ T* as_global(T* p) { return (T*)(GAS T*)(unsigned long long)p; }
__device__ __forceinline__ unsigned char* opq_p(unsigned char* p) { unsigned long long v = (unsigned long long)p; asm volatile("" : "+s"(v)); return (unsigned char*)(GAS unsigned char*)v; }
__device__ __forceinline__ int opq_s(int v) { asm volatile("" : "+s"(v)); return v; }
__device__ __forceinline__ int opq(int v) { asm volatile("" : "+v"(v)); return v; }
__device__ __forceinline__ float wave_sum(float v) {
#pragma unroll
    for (int o = 1; o < 64; o <<= 1) v += __shfl_xor(v, o);
    return v;
}

#define XB_TMO      128
#define XB_XCNT(j)  (256  + 64 * (j))
#define XB_XSUB(j)  (1280 + 64 * (j))
#define XB_XGEN(j)  (2304 + 64 * (j))
#define XB_TOP      3328
#define XB_TOPGEN   3392
#define XCD_BAR_WORDS 3456
#define XB_SPIN_CAP (1u << 18)
__device__ __forceinline__ unsigned xb_ld(unsigned* p)              { return __hip_atomic_load(p, __ATOMIC_RELAXED, __HIP_MEMORY_SCOPE_AGENT); }
__device__ __forceinline__ unsigned xb_add(unsigned* p, unsigned v) { return __hip_atomic_fetch_add(p, v, __ATOMIC_RELAXED, __HIP_MEMORY_SCOPE_AGENT); }
__device__ __forceinline__ unsigned xb_xcc_id() { return (unsigned)__builtin_amdgcn_s_getreg((3 << 11) | 20) & 0xFu; }
#define XB_SPIN(cond, bar) do { unsigned _sp = 0; while (cond) { __builtin_amdgcn_s_sleep(1); \
    if ((++_sp & 255u) == 0u) { if (xb_ld(&(bar)[XB_TMO])) break; if (_sp > XB_SPIN_CAP) { atomicAdd(&(bar)[XB_TMO], 1u); break; } } } } while (0)
struct XcdBarrier { unsigned* bar; unsigned x; volatile LAS unsigned* st; };
__device__ __forceinline__ XcdBarrier xcd_barrier_post(unsigned* bar, volatile LAS unsigned* st) {
    XcdBarrier b; b.bar = bar; b.x = xb_xcc_id(); b.st = st;
    if (threadIdx.x == 0) (void)xb_add(&bar[XB_XCNT(b.x)], 1u);
    return b;
}
__device__ __forceinline__ void xcd_barrier_complete(unsigned* bar, unsigned x, unsigned& nloc, unsigned& nx) {
    const unsigned G = gridDim.x * gridDim.y * gridDim.z;
    unsigned sum, cnt, mine, sp = 0u;
    for (;;) {
        sum = 0u; cnt = 0u; mine = 0u;
#pragma unroll
        for (unsigned j = 0; j < 16; ++j) { const unsigned c = xb_ld(&bar[XB_XCNT(j)]); sum += c; cnt += (c > 0u) ? 1u : 0u; mine = (j == x) ? c : mine; }
        if (sum == G) break;
        __builtin_amdgcn_s_sleep(1);
        if ((++sp & 255u) == 0u) { if (xb_ld(&bar[XB_TMO])) break; if (sp > XB_SPIN_CAP) { atomicAdd(&bar[XB_TMO], 1u); break; } }
    }
    nloc = mine > 0u ? mine : 1u; nx = cnt > 0u ? cnt : 1u;
}
__device__ __forceinline__ void xcd_barrier(const XcdBarrier& b, const bool leader) {
    asm volatile("s_waitcnt vmcnt(0)" ::: "memory");
    __syncthreads();
    if (leader) {
        unsigned* bar = b.bar;
        __builtin_amdgcn_s_waitcnt(0);
        unsigned nloc = b.st[0], nx = b.st[1];
        if (nloc == 0u) { xcd_barrier_complete(bar, b.x, nloc, nx); b.st[0] = nloc; b.st[1] = nx; }
        const unsigned old = xb_add(&bar[XB_XSUB(b.x)], 1u);
        const unsigned gen = old / nloc;
        if (old + 1u == (gen + 1u) * nloc) {
            __builtin_amdgcn_fence(__ATOMIC_RELEASE, "agent");
            asm volatile("s_waitcnt vmcnt(0)" ::: "memory");
            const unsigned og = xb_add(&bar[XB_TOP], 1u);
            const unsigned tg = og / nx;
            if (og + 1u == (tg + 1u) * nx) xb_add(&bar[XB_TOPGEN], 1u);
            else XB_SPIN(xb_ld(&bar[XB_TOPGEN]) == tg, bar);
            __builtin_amdgcn_fence(__ATOMIC_ACQUIRE, "agent");
            xb_add(&bar[XB_XGEN(b.x)], 1u);
            asm volatile("s_waitcnt vmcnt(0)" ::: "memory");
        } else {
            XB_SPIN(xb_ld(&bar[XB_XGEN(b.x)]) == gen, bar);
            __builtin_amdgcn_fence(__ATOMIC_ACQUIRE, "agent");
            asm volatile("s_waitcnt vmcnt(0)" ::: "memory");
        }
    }
    __syncthreads();
}

namespace pg8 {
constexpr float ATT_SC_ = 0.044194173824159216f * 1.4426950408889634f;
constexpr int BM = 256, BK = 64, HALF = 128, HTB = HALF * BK * 2, NXCD = 8, WGM = 8;
__host__ __device__ __forceinline__ int lds_byte(int r, int c) { const int st = (r >> 4) * 2 + (c >> 5), rr = r & 15, cc = c & 31, ob = rr * 64 + cc * 2; return st * 1024 + (ob ^ (((ob >> 9) & 1) << 5)); }
__host__ __device__ __forceinline__ void stage_rc(int b, int& R, int& C) { const int st = b / 1024, sb = b % 1024, swz = sb ^ (((sb >> 9) & 1) << 5); R = (st >> 1) * 16 + swz / 64; C = (st & 1) * 32 + (swz % 64) / 2; }
__host__ __device__ __forceinline__ int perm32(int rho) { const int n = rho >> 4, i = rho & 15; return 8 * (i >> 2) + 4 * n + (i & 3); }

struct Unit { const char* a; const char* b; char* c; int ldc; int cn; int nt; int lda, ldb; char* c2; int row0; };
__device__ __forceinline__ void tile_of(int wgid, int nM, int nN, int& pm, int& pn) {
    const int nwg = nM * nN;
    { const int q = nwg / NXCD, r = nwg % NXCD, xcd = wgid % NXCD, off = wgid / NXCD; wgid = (xcd < r ? xcd * (q + 1) : r * (q + 1) + (xcd - r) * q) + off; }
    const int nig = WGM * nN, gid = wgid / nig, fm = gid * WGM, gsz = (nM - fm) < WGM ? (nM - fm) : WGM;
    pm = fm + ((wgid % nig) % gsz); pn = (wgid % nig) / gsz;
}
struct SchedG {
    const char* A; const char* B; char* C; int lda, ldb, ldc, nM, nN, csz, G, c, grp_shift, grp_kbytes;
    __device__ __forceinline__ bool next(int i, Unit& u) const {
        const int L = i * G + c; if (L >= nM * nN) return false;
        int pm, pn; tile_of(L, nM, nN, pm, pn);
        u.a = A + (size_t)pm * BM * lda * 2 + (size_t)((pn >> grp_shift) * grp_kbytes);
        u.b = B + (size_t)pn * BM * ldb * 2;
        u.c = C + ((size_t)pm * BM * ldc + (size_t)pn * BM) * csz; u.ldc = ldc; u.cn = pn * BM; u.row0 = pm * BM; return true;
    }
};
struct SchedGS {
    const char* A; const char* B; char* C; char* SLAB; int lda, ldb, K, csz, G, c, ssz; int nU = 512;
    __device__ __forceinline__ bool next(int i, Unit& u) const {
        const int L = i * G + c; if (L >= nU) return false;
        u.ldc = D;
        if (L < 256) { int pm, pn; tile_of(L, 32, 8, pm, pn);
            u.a = A + (size_t)pm * BM * lda * 2; u.b = B + (size_t)pn * BM * ldb * 2; u.c = C + ((size_t)pm * BM * D + (size_t)pn * BM) * csz; u.cn = 0; u.nt = K / BK; u.row0 = pm * BM; }
        else { const int j = L - 256, ts = j >> 3, ks = j & 7, pm = ts >> 3, pn = ts & 7; const size_t kb = (size_t)ks * (K / 8) * 2;
            u.a = A + (size_t)(TP + pm * BM) * lda * 2 + kb; u.b = B + (size_t)pn * BM * ldb * 2 + kb;
            u.c = SLAB + (((size_t)ks * TS + pm * BM) * D + (size_t)pn * BM) * ssz; u.cn = 1; u.nt = K / (8 * BK); u.row0 = TP + pm * BM; }
        return true;
    }
};
struct SchedUP {
    const char* A; const char* B; char* C; int G, c; unsigned* flag;
    __device__ __forceinline__ bool next(int i, Unit& u) const {
        const int L = i * G + c; if (L >= 1152) return false;
        int pm, pn;
        if (G == 256) { if (L < 128) { const int j = L >> 3; pm = 32 + (j & 3); pn = 4 * (L & 7) + (j >> 2); } else tile_of(L - 128, 32, 32, pm, pn); }
        else tile_of(L, 36, 32, pm, pn);
        u.a = A + (size_t)pm * BM * D * 2; u.b = B + (size_t)pn * BM * D * 2;
        u.c = C + ((size_t)pm * BM * FF + (size_t)pn * BM) * 2; u.ldc = FF; u.cn = pn * BM; u.row0 = pm * BM; return true;
    }
};
struct SchedDS {
    const char* A; const char* B; char* SLAB; int c;
    __device__ __forceinline__ bool next(int i, Unit& u) const {
        if (i > 1 || c < 128) return false;
        const int j = 2 * (c - 128) + i, ts = j >> 3, ks = j & 7, pm = ts >> 3, pn = ts & 7; const size_t kb = (size_t)ks * (FF / 8) * 2;
        u.a = A + (size_t)(TP + pm * BM) * FF * 2 + kb; u.b = B + (size_t)pn * BM * FF * 2 + kb;
        u.c = SLAB + (((size_t)ks * TS + pm * BM) * D + (size_t)pn * BM) * 2; u.ldc = D; u.cn = 1; u.nt = FF / (8 * BK); u.row0 = TP + pm * BM; return true;
    }
};
struct SchedWP {
    const char* WOUTB; const char* WPS; char* WPT; int G, c;
    __device__ __forceinline__ bool next(int i, Unit& u) const {
        const int j = (G == 256) ? (((c & 3) == 3) ? (c >> 2) : -1) : c;
        if (i > 0 || j < 0 || j >= 64) return false;
        const int g = j >> 4, rt = (j >> 1) & 7, ct = j & 1;
        u.a = WOUTB + ((size_t)(rt * 256) * D + g * 512) * 2; u.b = WPS + ((size_t)(g * 512 + ct * 256) * 512) * 2;
        u.c = WPT + ((size_t)(rt * 256) * D + g * 512 + ct * 256) * 2; u.ldc = D; u.cn = 0; return true;
    }
};
struct SchedP1 {
    const char* HN; const char* WINA; char* QS; char* FL; char* VI; char* GS; const char* MEMN; const char* WXKV; char* OUTK; char* OUTV; char* KPB; char* VPB; int G, c;
    __device__ __forceinline__ bool next(int i, Unit& u) const {
        const int L = i * G + c; if (L >= 1280) return false;
        if (L < 1152) { int pm, pn; tile_of(L, 36, 32, pm, pn); const int reg = pn >> 3, pc = pn & 7;
            u.a = HN + (size_t)pm * BM * D * 2; u.b = WINA + (size_t)pn * BM * D * 2; u.ldc = D; u.row0 = pm * BM;
            const size_t eo = (size_t)pm * BM * D + (size_t)pc * BM;
            if (reg == 0) { u.c = QS + eo * 2; u.cn = 2; } else if (reg == 1) { u.c = FL + eo * 2; u.cn = 1; } else if (reg == 2) { u.c = VI + eo * 2; u.cn = 1; } else { u.c = GS + eo * 2; u.cn = 2; } }
        else { const int j = L - 1152, l = j >> 6, jj = j & 63, pm = jj & 3, pn = jj >> 2;
            u.a = MEMN + ((size_t)l * 1024 + pm * BM) * D * 2; u.b = WXKV + ((size_t)l * 4096 + pn * BM) * D * 2;
            const size_t eo2 = ((size_t)l * 1024 + pm * BM) * D + (size_t)(pn & 7) * BM;
            u.c = (pn < 8 ? OUTK : OUTV) + eo2 * 4; u.c2 = (pn < 8 ? KPB : VPB) + eo2 * 2; u.ldc = D; u.cn = 0; }
        return true;
    }
};
struct EpiF32 {
    static constexpr bool PERM = false; float oscale;
    __device__ __forceinline__ void operator()(const f32x4 (&acc)[2][2][4][2], const Unit& u, int wr, int wc, int fr_, int fq_) const {
        const int fr = opq(fr_), fq = opq(fq_);
        const int row0 = wr * 64 + fr, col0 = wc * 32 + 4 * fq; float* C = as_global((float*)u.c);
#pragma unroll
        for (int ai = 0; ai < 2; ++ai)
#pragma unroll
            for (int m = 0; m < 4; ++m) { float* rowp = C + (size_t)(row0 + ai * HALF + m * 16) * u.ldc + col0;
#pragma unroll
                for (int bj = 0; bj < 2; ++bj)
#pragma unroll
                    for (int n = 0; n < 2; ++n) *(f32x4*)(rowp + bj * HALF + n * 16) = acc[ai][bj][m][n] * oscale; }
    }
};
struct EpiP1 {
    static constexpr bool PERM = true; const float* rs;
    __device__ __forceinline__ void operator()(const f32x4 (&acc)[2][2][4][2], const Unit& u, int wr, int wc, int fr_, int fq_) const {
        const int fr = opq(fr_), fq = opq(fq_);
        const int row0 = wr * 64 + fr, col0 = wc * 32 + 8 * fq;
        if (u.cn == 0) { float* C = as_global((float*)u.c); bf16* C2 = as_global((bf16*)u.c2);
#pragma unroll
            for (int ai = 0; ai < 2; ++ai)
#pragma unroll
                for (int m = 0; m < 4; ++m) { const size_t ro = (size_t)(row0 + ai * HALF + m * 16) * u.ldc + col0;
#pragma unroll
                    for (int bj = 0; bj < 2; ++bj) { const f32x4 v0 = acc[ai][bj][m][0], v1 = acc[ai][bj][m][1];
                        __builtin_nontemporal_store(v0, (f32x4*)(C + ro + bj * HALF)); __builtin_nontemporal_store(v1, (f32x4*)(C + ro + bj * HALF + 4));
                        v4u w; w.x = cvt_pk_bf16(v0[0], v0[1]); w.y = cvt_pk_bf16(v0[2], v0[3]); w.z = cvt_pk_bf16(v1[0], v1[1]); w.w = cvt_pk_bf16(v1[2], v1[3]);
                        *(v4u*)(C2 + ro + bj * HALF) = w; } }
        } else if (u.cn == 1) { bf16* O = as_global((bf16*)u.c);
#pragma unroll
            for (int ai = 0; ai < 2; ++ai)
#pragma unroll
                for (int m = 0; m < 4; ++m) { bf16* rowp = O + (size_t)(row0 + ai * HALF + m * 16) * u.ldc + col0; const float rsv = rs[u.row0 + row0 + ai * HALF + m * 16];
#pragma unroll
                    for (int bj = 0; bj < 2; ++bj) { const f32x4 v0 = acc[ai][bj][m][0] * rsv, v1 = acc[ai][bj][m][1] * rsv;
                        v4u w; w.x = cvt_pk_bf16(v0[0], v0[1]); w.y = cvt_pk_bf16(v0[2], v0[3]); w.z = cvt_pk_bf16(v1[0], v1[1]); w.w = cvt_pk_bf16(v1[2], v1[3]);
                        *(v4u*)(rowp + bj * HALF) = w; } }
        } else { bf16* O = as_global((bf16*)u.c);
#pragma unroll
            for (int ai = 0; ai < 2; ++ai)
#pragma unroll
                for (int m = 0; m < 4; ++m) { bf16* rowp = O + (size_t)(row0 + ai * HALF + m * 16) * u.ldc + col0; const float rsv = rs[u.row0 + row0 + ai * HALF + m * 16];
#pragma unroll
                    for (int bj = 0; bj < 2; ++bj) { f32x4 v0 = acc[ai][bj][m][0] * rsv, v1 = acc[ai][bj][m][1] * rsv;
#pragma unroll
                        for (int j = 0; j < 4; ++j) { v0[j] = v0[j] * __builtin_amdgcn_rcpf(1.0f + __expf(-v0[j])); v1[j] = v1[j] * __builtin_amdgcn_rcpf(1.0f + __expf(-v1[j])); }
                        v4u w; w.x = cvt_pk_bf16(v0[0], v0[1]); w.y = cvt_pk_bf16(v0[2], v0[3]); w.z = cvt_pk_bf16(v1[0], v1[1]); w.w = cvt_pk_bf16(v1[2], v1[3]);
                        *(v4u*)(rowp + bj * HALF) = w; } }
        }
    }
};
template <int ACT  > struct EpiBf16 {
    static constexpr bool PERM = true;
    const float* scale;
    __device__ __forceinline__ void operator()(const f32x4 (&acc)[2][2][4][2], const Unit& u, int wr, int wc, int fr_, int fq_) const {
        const int fr = opq(fr_), fq = opq(fq_);
        const int row0 = wr * 64 + fr, col0 = wc * 32 + 8 * fq; bf16* O = as_global((bf16*)u.c);
        f32x4 sv[2][2];
#pragma unroll
        for (int bj = 0; bj < 2; ++bj)
#pragma unroll
            for (int n = 0; n < 2; ++n) sv[bj][n] = (ACT == 2) ? *(const f32x4*)(scale + u.cn + col0 + bj * HALF + 4 * n) : (f32x4){1.f, 1.f, 1.f, 1.f};
#pragma unroll
        for (int ai = 0; ai < 2; ++ai)
#pragma unroll
            for (int m = 0; m < 4; ++m) { bf16* rowp = O + (size_t)(row0 + ai * HALF + m * 16) * u.ldc + col0;
                const float rsv = (ACT != 2 && scale) ? scale[u.row0 + row0 + ai * HALF + m * 16] : 1.0f;
#pragma unroll
                for (int bj = 0; bj < 2; ++bj) { f32x4 v0 = acc[ai][bj][m][0] * rsv, v1 = acc[ai][bj][m][1] * rsv;
                    if (ACT == 1) {
#pragma unroll
                        for (int j = 0; j < 4; ++j) { const float a = fmaxf(v0[j], 0.f), b = fmaxf(v1[j], 0.f); v0[j] = a * a; v1[j] = b * b; } }
                    if (ACT == 2) { v0 = v0 * sv[bj][0]; v1 = v1 * sv[bj][1]; }
                    v4u w; w.x = cvt_pk_bf16(v0[0], v0[1]); w.y = cvt_pk_bf16(v0[2], v0[3]); w.z = cvt_pk_bf16(v1[0], v1[1]); w.w = cvt_pk_bf16(v1[2], v1[3]);
                    *(v4u*)(rowp + bj * HALF) = w; } }
    }
};

struct SchedWK {
    const char* KPB; const char* WXQN; char* WKT; int G, c, first;
    __device__ __forceinline__ bool next(int i, Unit& u) const {
        const int j = c - first; if (i > 0 || j < 0 || j >= 128) return false;
        const int b = j >> 5, h = (j >> 3) & 3, kt = j & 7;
        u.a = KPB + ((size_t)(b * 256) * D + h * 512) * 2; u.b = WXQN + ((size_t)(kt * 256) * D + h * 512) * 2;
        u.c = WKT + ((size_t)(b * 1024 + h * 256) * D + (size_t)kt * 256) * 2; u.ldc = D; u.cn = 0; u.row0 = 0; return true;
    }
};
struct SchedS {
    const char* XB; const char* WKT; char* P; int G, c;
    __device__ __forceinline__ bool next(int i, Unit& u) const {
        const int L = c; if (i > 0 || L >= 128) return false;
        const int b = L >> 5, h = (L >> 3) & 3, rt = L & 7;
        u.a = XB + ((size_t)(b * SEQ + rt * 256) * D) * 2; u.b = WKT + ((size_t)(b * 1024 + h * 256) * D) * 2;
        u.c = P + ((size_t)(b * SEQ + rt * 256) * 1024 + h * 256) * 2; u.ldc = 1024; u.cn = 0; u.row0 = b * SEQ + rt * 256; return true;
    }
};
struct SchedXQS {
    const char* XB; const char* WXQ; char* SLAB; int G, c;
    __device__ __forceinline__ bool next(int i, Unit& u) const {
        const int j = (c - 128) * 2 + i; if (i > 1 || c < 128 || c >= 256) return false;
        const int ts = j >> 3, ks = j & 7, pm = ts >> 3, pn = ts & 7; const size_t kb = (size_t)ks * (D / 8) * 2;
        u.a = XB + (size_t)(TP + pm * BM) * D * 2 + kb; u.b = WXQ + (size_t)pn * BM * D * 2 + kb;
        u.c = SLAB + (((size_t)ks * TS + pm * BM) * D + (size_t)pn * BM) * 2; u.ldc = D; u.cn = 1; u.nt = 4; u.row0 = TP + pm * BM; return true;
    }
};
struct SchedAtt1V {
    const char* Q; const char* KPB; char* P; const char* WXO; const char* VPB; char* VWT; int G, c, which;
    __device__ __forceinline__ bool next(int i, Unit& u) const {
        const int L = i * G + c; if (L >= 256 || (L < 128) != (which == 0)) return false;
        if (L < 128) { const int b = L >> 5, h = (L >> 3) & 3, rt = L & 7;
            u.a = Q + ((size_t)(b * SEQ + rt * 256) * D + h * 512) * 2; u.b = KPB + ((size_t)(b * 256) * D + h * 512) * 2;
            u.c = P + ((size_t)(b * SEQ + rt * 256) * 1024 + h * 256) * 2; u.ldc = 1024; u.cn = 0; }
        else { const int j = L - 128, b = j >> 5, h = (j >> 3) & 3, n8 = j & 7;
            u.a = WXO + ((size_t)(n8 * 256) * D + h * 512) * 2; u.b = VPB + ((size_t)(b * 256) * D + h * 512) * 2;
            u.c = VWT + ((size_t)(b * D + n8 * 256) * 1024 + h * 256) * 2; u.ldc = 1024; u.cn = 0; }
        return true;
    }
};
struct SchedXO {
    const char* P; const char* VWT; char* M; const char* AO; const char* WXO; char* SLAB; int G, c;
    __device__ __forceinline__ bool next(int i, Unit& u) const {
        const int L = i * G + c; if (L >= 512) return false;
        u.ldc = D;
        if (L < 256) { const int x = L & 7, q = L >> 3, panel = x * 4 + (q >> 3), pn = q & 7, b = panel >> 3, rt = panel & 7;
            u.a = P + ((size_t)(b * SEQ + rt * 256) * 1024) * 2; u.b = VWT + ((size_t)(b * D + pn * 256) * 1024) * 2;
            u.c = M + ((size_t)(b * SEQ + rt * 256) * D + (size_t)pn * 256) * 2; u.cn = 0; u.nt = 16; u.lda = 1024; u.ldb = 1024; }
        else { const int j = L - 256, ts = j >> 3, ks = j & 7, pm = ts >> 3, pn = ts & 7; const size_t kb = (size_t)ks * (D / 8) * 2;
            u.a = AO + (size_t)(TP + pm * BM) * D * 2 + kb; u.b = WXO + (size_t)pn * BM * D * 2 + kb;
            u.c = SLAB + (((size_t)ks * TS + pm * BM) * D + (size_t)pn * BM) * 2; u.cn = 1; u.nt = 4; u.lda = D; u.ldb = D; }
        return true;
    }
};
struct SchedAtt1 {
    const char* Q; const char* KPB; char* P; int G, c;
    __device__ __forceinline__ bool next(int i, Unit& u) const {
        const int L = i * G + c; if (L >= 128) return false;
        const int b = L >> 5, h = (L >> 3) & 3, rt = L & 7;
        u.a = Q + ((size_t)(b * SEQ + rt * 256) * D + h * 512) * 2; u.b = KPB + ((size_t)(b * 256) * D + h * 512) * 2;
        u.c = P + ((size_t)(b * SEQ + rt * 256) * 1024 + h * 256) * 2; u.ldc = 1024; u.cn = 0; return true;
    }
};
struct SchedAtt2 {
    const char* P; const char* VPT; char* AO; int G, c;
    __device__ __forceinline__ bool next(int i, Unit& u) const {
        const int L = i * G + c; if (L >= 256) return false;
        const int b = L >> 6, h = (L >> 4) & 3, rt = (L >> 1) & 7, nh = L & 1;
        u.a = P + ((size_t)(b * SEQ + rt * 256) * 1024 + h * 256) * 2; u.b = VPT + ((size_t)((b * 4 + h) * 512 + nh * 256) * 256) * 2;
        u.c = AO + ((size_t)(b * SEQ + rt * 256) * D + h * 512 + nh * 256) * 2; u.ldc = D; u.cn = 0; return true;
    }
};
struct EpiSoftmax {
    static constexpr bool PERM = true;
    LAS unsigned char* xl; const float* rs;
    __device__ __forceinline__ void operator()(f32x4 (&acc)[2][2][4][2], const Unit& u, int wr, int wc, int fr_, int fq_) const {
        const int fr = opq(fr_), fq = opq(fq_);
        LAS float* smax = (LAS float*)xl; LAS float* ssum = smax + 1024;
        const int row0 = wr * 64 + fr, col0 = wc * 32 + 8 * fq; bf16* O = as_global((bf16*)u.c);
#pragma unroll
        for (int ai = 0; ai < 2; ++ai)
#pragma unroll
            for (int m = 0; m < 4; ++m) { float mx = -3.0e38f; const float rsc = rs ? ATT_SC_ * rs[u.row0 + row0 + ai * HALF + m * 16] : ATT_SC_;
#pragma unroll
                for (int bj = 0; bj < 2; ++bj)
#pragma unroll
                    for (int n = 0; n < 2; ++n) { acc[ai][bj][m][n] = acc[ai][bj][m][n] * rsc; const f32x4 x = acc[ai][bj][m][n]; mx = fmaxf(mx, fmaxf(fmaxf(x[0], x[1]), fmaxf(x[2], x[3]))); }
                mx = fmaxf(mx, __shfl_xor(mx, 16)); mx = fmaxf(mx, __shfl_xor(mx, 32));
                if (fq == 0) smax[(row0 + ai * HALF + m * 16) * 4 + wc] = mx; }
        asm volatile("s_waitcnt lgkmcnt(0)" ::: "memory"); __builtin_amdgcn_s_barrier(); asm volatile("" ::: "memory");
#pragma unroll
        for (int ai = 0; ai < 2; ++ai)
#pragma unroll
            for (int m = 0; m < 4; ++m) { const f32x4 mv = *(const LAS f32x4*)(smax + (row0 + ai * HALF + m * 16) * 4); const float M = fmaxf(fmaxf(mv[0], mv[1]), fmaxf(mv[2], mv[3])); float sm = 0.f;
#pragma unroll
                for (int bj = 0; bj < 2; ++bj)
#pragma unroll
                    for (int n = 0; n < 2; ++n) {
#pragma unroll
                        for (int e = 0; e < 4; ++e) { const float pv = __builtin_amdgcn_exp2f(acc[ai][bj][m][n][e] - M); acc[ai][bj][m][n][e] = pv; sm += pv; } }
                sm += __shfl_xor(sm, 16); sm += __shfl_xor(sm, 32);
                if (fq == 0) ssum[(row0 + ai * HALF + m * 16) * 4 + wc] = sm; }
        asm volatile("s_waitcnt lgkmcnt(0)" ::: "memory"); __builtin_amdgcn_s_barrier(); asm volatile("" ::: "memory");
#pragma unroll
        for (int ai = 0; ai < 2; ++ai)
#pragma unroll
            for (int m = 0; m < 4; ++m) { const f32x4 sv = *(const LAS f32x4*)(ssum + (row0 + ai * HALF + m * 16) * 4); const float inv = 1.0f / ((sv[0] + sv[1]) + (sv[2] + sv[3]));
                bf16* rowp = O + (size_t)(opq(row0) + ai * HALF + m * 16) * u.ldc + opq(col0);
#pragma unroll
                for (int bj = 0; bj < 2; ++bj) { const f32x4 v0 = acc[ai][bj][m][0] * inv, v1 = acc[ai][bj][m][1] * inv;
                    v4u w; w.x = cvt_pk_bf16(v0[0], v0[1]); w.y = cvt_pk_bf16(v0[2], v0[3]); w.z = cvt_pk_bf16(v1[0], v1[1]); w.w = cvt_pk_bf16(v1[2], v1[3]);
                    *(v4u*)(rowp + bj * HALF) = w; } }
    }
};

template <class Epi, class Sched, bool SMALLK = false, bool SPLIT = false, bool MIX = false, bool SIG = false>
__device__ __forceinline__ void gemm_phase(LAS unsigned char* lds, const int wid_, const int lda, const int ldb, const int K, const Sched& S, const Epi& E) {
    const int wid = opq_s(wid_); const int lane = lane_id(), tid = wid * 64 + lane, wr = wid >> 2, wc = wid & 3, fr = lane & 15, fq = lane >> 4;
    const int nt0 = SMALLK ? opq_s(K / BK) : K / BK;
    unsigned voffA[2], voffB[2], nvoffA[2], nvoffB[2]; int sR[2], sC[2], sRb[2];
#pragma unroll
    for (int i = 0; i < 2; ++i) { int R, C; stage_rc(tid * 16 + i * 8192, R, C); const int Rb = Epi::PERM ? ((R & ~31) + perm32(R & 31)) : R; sR[i] = R; sC[i] = C; sRb[i] = Rb;
        voffA[i] = (unsigned)(R * lda + C) * 2u; voffB[i] = (unsigned)(Rb * ldb + C) * 2u; nvoffA[i] = voffA[i]; nvoffB[i] = voffB[i]; }
    const size_t kstep = (size_t)(BK * 2);
    size_t hstepA = (size_t)HALF * lda * 2, hstepB = (size_t)HALF * ldb * 2, nhstepA = hstepA, nhstepB = hstepB;
    const unsigned ldsw = (unsigned)wid * 1024u;
    const int aoff = lds_byte(wr * 64 + fr, fq * 8), boff = lds_byte(wc * 32 + fr, fq * 8);
#define PG8_SA(b, h) (((b) * 2 + (h)) * HTB)
#define PG8_SB(b, h) ((4 + (b) * 2 + (h)) * HTB)
#define PG8_STAGE(bufoff, gbase, voff) do { _Pragma("unroll") for (int _i = 0; _i < 2; ++_i) \
        __builtin_amdgcn_global_load_lds((const unsigned*)((const char*)(gbase) + (voff)[_i]), (LAS unsigned*)(lds + (bufoff) + ldsw + _i * 8192), 16, 0, 0); } while (0)
#define PG8_LDA(dst, b, h) do { _Pragma("unroll") for (int m = 0; m < 4; ++m) _Pragma("unroll") for (int k = 0; k < 2; ++k) dst[m][k] = *(const LAS bf16x8*)(lds + PG8_SA(b, h) + aoff + m * 2048 + k * 1024); } while (0)
#define PG8_LDB(dst, b, h) do { _Pragma("unroll") for (int n = 0; n < 2; ++n) _Pragma("unroll") for (int k = 0; k < 2; ++k) dst[n][k] = *(const LAS bf16x8*)(lds + PG8_SB(b, h) + boff + n * 2048 + k * 1024); } while (0)
#define PG8_MMA(ai, bj, At, Bt) do { __builtin_amdgcn_s_setprio(1); _Pragma("unroll") for (int m = 0; m < 4; ++m) _Pragma("unroll") for (int n = 0; n < 2; ++n) _Pragma("unroll") for (int k = 0; k < 2; ++k) \
        acc[ai][bj][m][n] = __builtin_amdgcn_mfma_f32_16x16x32_bf16(Bt[n][k], At[m][k], acc[ai][bj][m][n], 0, 0, 0); __builtin_amdgcn_s_setprio(0); } while (0)
#define PG8_WAIT_V(n) asm volatile("s_waitcnt vmcnt(" #n ")" ::: "memory")
#define PG8_WAIT_L(n) asm volatile("s_waitcnt lgkmcnt(" #n ")" ::: "memory")
#define PG8_BAR __builtin_amdgcn_s_barrier()
#define PG8_SCHED __builtin_amdgcn_sched_barrier(0)
    Unit cur, nxt; int ui = 0;
    if (!S.next(0, cur)) return;
    f32x4 acc[2][2][4][2];
#pragma unroll
    for (int a = 0; a < 2; ++a)
#pragma unroll
        for (int b = 0; b < 2; ++b)
#pragma unroll
            for (int m = 0; m < 4; ++m)
#pragma unroll
                for (int n = 0; n < 2; ++n) acc[a][b][m][n] = (f32x4){0.f, 0.f, 0.f, 0.f};
    bf16x8 At[4][2], B0[2][2], B1[2][2];
    const char* cA = cur.a; const char* cB = cur.b;
    if constexpr (MIX) {
#pragma unroll
        for (int i = 0; i < 2; ++i) { voffA[i] = (unsigned)(sR[i] * cur.lda + sC[i]) * 2u; voffB[i] = (unsigned)(sRb[i] * cur.ldb + sC[i]) * 2u; }
        hstepA = (size_t)HALF * cur.lda * 2; hstepB = (size_t)HALF * cur.ldb * 2; }
    PG8_STAGE(PG8_SB(0, 0), cB, voffB); PG8_STAGE(PG8_SB(0, 1), cB + hstepB, voffB); PG8_STAGE(PG8_SA(0, 0), cA, voffA); PG8_STAGE(PG8_SA(0, 1), cA + hstepA, voffA);
    if (wr == 1) PG8_BAR;
    PG8_WAIT_V(2); PG8_BAR;
    PG8_STAGE(PG8_SB(1, 0), cB + kstep, voffB); PG8_STAGE(PG8_SA(1, 0), cA + kstep, voffA); PG8_STAGE(PG8_SB(1, 1), cB + hstepB + kstep, voffB);
    PG8_WAIT_V(6); PG8_BAR;
    for (;;) {
        const bool has_next = S.next(ui + 1, nxt);
        const char* nA = has_next ? nxt.a : cA; const char* nB = has_next ? nxt.b : cB;
        if constexpr (MIX) { const int la = has_next ? nxt.lda : cur.lda, lb = has_next ? nxt.ldb : cur.ldb;
#pragma unroll
            for (int i = 0; i < 2; ++i) { nvoffA[i] = (unsigned)(sR[i] * la + sC[i]) * 2u; nvoffB[i] = (unsigned)(sRb[i] * lb + sC[i]) * 2u; }
            nhstepA = (size_t)HALF * la * 2; nhstepB = (size_t)HALF * lb * 2; }
#define PG8_KITER \
            const bool last = (t == nt - 2); \
            const char* a1 = cA + (size_t)(t + 1) * kstep; \
            const char* a2 = last ? nA : cA + (size_t)(t + 2) * kstep; const char* b2 = last ? nB : cB + (size_t)(t + 2) * kstep; \
            const char* a3 = a2 + kstep; const char* b3 = b2 + kstep; \
            const bool nx_ = MIX && last; const unsigned vA2[2] = {nx_ ? nvoffA[0] : voffA[0], nx_ ? nvoffA[1] : voffA[1]}, vB2[2] = {nx_ ? nvoffB[0] : voffB[0], nx_ ? nvoffB[1] : voffB[1]}; \
            const size_t hA2 = nx_ ? nhstepA : hstepA, hB2 = nx_ ? nhstepB : hstepB; \
            PG8_LDB(B0, 0, 0); PG8_LDB(B1, 0, 1); PG8_SCHED; PG8_LDA(At, 0, 0); PG8_STAGE(PG8_SA(1, 1), a1 + hstepA, voffA); \
            PG8_WAIT_V(8); PG8_WAIT_L(0); PG8_BAR; PG8_MMA(0, 0, At, B0); PG8_MMA(0, 1, At, B1); PG8_BAR; PG8_SCHED; \
            PG8_LDA(At, 0, 1); PG8_STAGE(PG8_SB(0, 0), b2, vB2); PG8_STAGE(PG8_SB(0, 1), b2 + hB2, vB2); PG8_STAGE(PG8_SA(0, 0), a2, vA2); \
            PG8_WAIT_V(8); PG8_WAIT_L(0); PG8_BAR; PG8_MMA(1, 0, At, B0); PG8_MMA(1, 1, At, B1); PG8_BAR; PG8_SCHED; \
            PG8_LDB(B0, 1, 0); PG8_LDB(B1, 1, 1); PG8_SCHED; PG8_LDA(At, 1, 0); PG8_STAGE(PG8_SA(0, 1), a2 + hA2, vA2); \
            PG8_WAIT_V(8); PG8_WAIT_L(0); PG8_BAR; PG8_MMA(0, 0, At, B0); PG8_MMA(0, 1, At, B1); PG8_BAR; PG8_SCHED; \
            PG8_LDA(At, 1, 1); PG8_STAGE(PG8_SB(1, 0), b3, vB2); PG8_STAGE(PG8_SB(1, 1), b3 + hB2, vB2); PG8_STAGE(PG8_SA(1, 0), a3, vA2); \
            PG8_WAIT_V(8); PG8_WAIT_L(0); PG8_BAR; PG8_MMA(1, 0, At, B0); PG8_MMA(1, 1, At, B1); PG8_BAR; PG8_SCHED;
        const int nt = SPLIT ? cur.nt : nt0;
        if constexpr (SMALLK || SPLIT) {
#pragma unroll 1
            for (int t = 0; t < nt; t += 2) { PG8_KITER }
        } else {
            for (int t = 0; t < nt; t += 2) { PG8_KITER }
        }
        if (wr == 0) PG8_BAR;
        E(acc, cur, wr, wc, fr, fq);
        if constexpr (SIG) { if (cur.row0 >= TP) {
            asm volatile("s_waitcnt vmcnt(0)" ::: "memory"); PG8_BAR;
            if (tid == 0) { __builtin_amdgcn_fence(__ATOMIC_RELEASE, "agent"); asm volatile("s_waitcnt vmcnt(0)" ::: "memory"); (void)xb_add(S.flag, 1u); } } }
        if (!has_next) break;
#pragma unroll
        for (int a = 0; a < 2; ++a)
#pragma unroll
            for (int b = 0; b < 2; ++b)
#pragma unroll
                for (int m = 0; m < 4; ++m)
#pragma unroll
                    for (int n = 0; n < 2; ++n) acc[a][b][m][n] = (f32x4){0.f, 0.f, 0.f, 0.f};
        cur = nxt; cA = nA; cB = nB; ++ui;
        if constexpr (MIX) { voffA[0] = nvoffA[0]; voffA[1] = nvoffA[1]; voffB[0] = nvoffB[0]; voffB[1] = nvoffB[1]; hstepA = nhstepA; hstepB = nhstepB; }
        if (wr == 1) PG8_BAR;
    }
    PG8_WAIT_V(0);
    PG8_BAR;
#undef PG8_KITER
#undef PG8_SA
#undef PG8_SB
#undef PG8_STAGE
#undef PG8_LDA
#undef PG8_LDB
#undef PG8_MMA
#undef PG8_WAIT_V
#undef PG8_WAIT_L
#undef PG8_BAR
#undef PG8_SCHED
}
}

struct Args { const float* in[27]; float* out; unsigned char* ws; int ph_lo, ph_hi; };
struct Frame {
    LAS unsigned char* lds; unsigned char* ws; float* out;
    int wave, G, gw, ngw;
};

__device__ __forceinline__ void tr_load(f32x4 (&v)[8], const float* W, int ldw, int k0, int n0, int lane, const float* kscale = nullptr) {
    const float* src = W + (size_t)(k0 + 8 * (lane >> 3)) * ldw + n0 + 4 * (lane & 7);
#pragma unroll
    for (int j = 0; j < 8; ++j) v[j] = *(const f32x4*)(src + (size_t)j * ldw);
    if (kscale) {
#pragma unroll
        for (int j = 0; j < 8; ++j) v[j] = v[j] * kscale[k0 + 8 * (lane >> 3) + j]; }
}
__device__ __forceinline__ void tr_store(const f32x4 (&v)[8], bf16* WT, int ldt, int k0, int n0, int lane) {
    bf16* dst = WT + (size_t)(n0 + 4 * (lane & 7)) * ldt + k0 + 8 * (lane >> 3);
#pragma unroll
    for (int e = 0; e < 4; ++e) { v4u o; o.x = cvt_pk_bf16(v[0][e], v[1][e]); o.y = cvt_pk_bf16(v[2][e], v[3][e]); o.z = cvt_pk_bf16(v[4][e], v[5][e]); o.w = cvt_pk_bf16(v[6][e], v[7][e]);
        *(v4u*)(dst + (size_t)e * ldt) = o; }
}
__device__ __forceinline__ int tr_matrix(const Frame& F, const float* W, int K, int N, int ldw, bf16* WT, int ldt, int it0, const float* kscale = nullptr) {
    const int nnb = N / 32, nit = (K / 64) * nnb; const int lane = lane_id();
    int first = (F.gw - it0) % F.ngw; if (first < 0) first += F.ngw;
    for (int it = first; it < nit; it += 2 * F.ngw) { const int it2 = it + F.ngw; const bool two = it2 < nit;
        f32x4 a[8], b[8];
        tr_load(a, W, ldw, (it / nnb) * 64, (it % nnb) * 32, lane, kscale);
        if (two) tr_load(b, W, ldw, (it2 / nnb) * 64, (it2 % nnb) * 32, lane, kscale);
        tr_store(a, WT, ldt, (it / nnb) * 64, (it % nnb) * 32, lane);
        if (two) tr_store(b, WT, ldt, (it2 / nnb) * 64, (it2 % nnb) * 32, lane); }
    return it0 + nit;
}
__device__ __forceinline__ void norm_row(const float* xrow, const float* w, bf16* orow, float* xcopy, int lane) {
    f32x4 v[8]; float ss = 0.f;
#pragma unroll
    for (int j = 0; j < 8; ++j) { v[j] = *(const f32x4*)(xrow + 4 * lane + 256 * j); ss += (v[j][0] * v[j][0] + v[j][1] * v[j][1]) + (v[j][2] * v[j][2] + v[j][3] * v[j][3]); }
    const float r = 1.0f / sqrtf(wave_sum(ss) * (1.0f / D) + EPS);
#pragma unroll
    for (int j = 0; j < 8; ++j) { const f32x4 wv = *(const f32x4*)(w + 4 * lane + 256 * j); const f32x4 y = v[j] * r * wv;
        if (xcopy) *(f32x4*)(xcopy + 4 * lane + 256 * j) = v[j];
        v2u o; o.x = cvt_pk_bf16(y[0], y[1]); o.y = cvt_pk_bf16(y[2], y[3]); *(v2u*)(orow + 4 * lane + 256 * j) = o; }
}
struct TRow { f32x4 v[8], x[8]; };
__device__ __forceinline__ void bf8_to_f32(const v4u w, f32x4& lo, f32x4& hi) { lo = (f32x4){bf_lo(w.x), bf_hi(w.x), bf_lo(w.y), bf_hi(w.y)}; hi = (f32x4){bf_lo(w.z), bf_hi(w.z), bf_lo(w.w), bf_hi(w.w)}; }
__device__ __forceinline__ void t_load(TRow& t, const bf16* Msrc, const float* SLAB, const bf16* XB, const float* Xp, const float* Xs, int row, int lane) {
    if (row >= TP) { const bf16* sr = (const bf16*)SLAB + (size_t)(row - TP) * D + 8 * lane;
#pragma unroll
        for (int j = 0; j < 4; ++j) { bf8_to_f32(__builtin_nontemporal_load((const v4u*)(sr + 512 * j)), t.v[2 * j], t.v[2 * j + 1]);
#pragma unroll
            for (int ks = 1; ks < 8; ++ks) { f32x4 a, b; bf8_to_f32(__builtin_nontemporal_load((const v4u*)(sr + (size_t)ks * TS * D + 512 * j)), a, b); t.v[2 * j] += a; t.v[2 * j + 1] += b; } } }
    else { const bf16* mr = Msrc + (size_t)row * D + 8 * lane;
#pragma unroll
        for (int j = 0; j < 4; ++j) bf8_to_f32(__builtin_nontemporal_load((const v4u*)(mr + 512 * j)), t.v[2 * j], t.v[2 * j + 1]); }
    if (Xp) { const float* xr = (row < TP ? Xp + (size_t)row * D : Xs + (size_t)(row - TP) * D) + 8 * lane;
#pragma unroll
        for (int j = 0; j < 4; ++j) { t.x[2 * j] = *(const f32x4*)(xr + 512 * j); t.x[2 * j + 1] = *(const f32x4*)(xr + 512 * j + 4); } }
    else { const bf16* xr = XB + (size_t)row * D + 8 * lane;
#pragma unroll
        for (int j = 0; j < 4; ++j) bf8_to_f32(*(const v4u*)(xr + 512 * j), t.x[2 * j], t.x[2 * j + 1]); }
}
__device__ __forceinline__ float t_ss(const f32x4 (&v)[8]) { float ss = 0.f;
#pragma unroll
    for (int j = 0; j < 8; ++j) ss += (v[j][0] * v[j][0] + v[j][1] * v[j][1]) + (v[j][2] * v[j][2] + v[j][3] * v[j][3]);
    return ss; }
__device__ __forceinline__ v4u f32_to_bf8(const f32x4 lo, const f32x4 hi) { v4u o; o.x = cvt_pk_bf16(lo[0], lo[1]); o.y = cvt_pk_bf16(lo[2], lo[3]); o.z = cvt_pk_bf16(hi[0], hi[1]); o.w = cvt_pk_bf16(hi[2], hi[3]); return o; }
__device__ __forceinline__ void t_phase(const Frame& F, const bf16* Msrc, const float* SLAB, bf16* XB, float* Yout, const float* wpost, float* RS, const float* Xp = nullptr, const float* Xs = nullptr) {
    const int lane = lane_id();
    const bool deal = F.ngw == 2048; const int gw = F.gw;
    const int nrows = deal ? (gw < 1024 ? 4 : 5) : (gw < MT ? (MT - gw + F.ngw - 1) / F.ngw : 0);
#define T_ROW(k) (deal ? (gw < 1024 ? ((k) == 0 ? TP + gw : 3 * gw + (k) - 1) : 3072 + 5 * (gw - 1024) + (k)) : gw + (k) * F.ngw)
    f32x4 wq[8];
#pragma unroll
    for (int j = 0; j < 4; ++j) { wq[2 * j] = *(const f32x4*)(wpost + 8 * lane + 512 * j); wq[2 * j + 1] = *(const f32x4*)(wpost + 8 * lane + 512 * j + 4); }
    TRow cur, nxt;
    if (nrows > 0) t_load(cur, Msrc, SLAB, XB, Xp, Xs, T_ROW(0), lane);
#pragma unroll 1
    for (int k = 0; k < nrows; ++k) {
        const int row = T_ROW(k);
        if (k + 1 < nrows) t_load(nxt, Msrc, SLAB, XB, Xp, Xs, T_ROW(k + 1), lane);
        const float r = 1.0f / sqrtf(wave_sum(t_ss(cur.v)) * (1.0f / D) + EPS);
#pragma unroll
        for (int j = 0; j < 4; ++j) { cur.v[2 * j] = cur.x[2 * j] + cur.v[2 * j] * r * wq[2 * j]; cur.v[2 * j + 1] = cur.x[2 * j + 1] + cur.v[2 * j + 1] * r * wq[2 * j + 1]; }
        if (Yout) { float* yr = Yout + (size_t)row * D + 8 * lane;
#pragma unroll
            for (int j = 0; j < 4; ++j) { __builtin_nontemporal_store(cur.v[2 * j], (f32x4*)(yr + 512 * j)); __builtin_nontemporal_store(cur.v[2 * j + 1], (f32x4*)(yr + 512 * j + 4)); } }
        else { bf16* xr = XB + (size_t)row * D + 8 * lane;
#pragma unroll
            for (int j = 0; j < 4; ++j) *(v4u*)(xr + 512 * j) = f32_to_bf8(cur.v[2 * j], cur.v[2 * j + 1]); }
        if (RS) { const float r2 = 1.0f / sqrtf(wave_sum(t_ss(cur.v)) * (1.0f / D) + EPS); if (lane == 0) RS[row] = r2; }
        cur = nxt;
    }
#undef T_ROW
}

struct PrepIn { unsigned qv[16], vv[16], fv[16]; };
__device__ __forceinline__ void prep_load(PrepIn& in, const bf16* QS, const bf16* FL, const bf16* VI, const bf16* GS, int c, int h, int lane) {
    const int nt = c < 512 ? 16 : 8;
    const size_t row0 = c < 512 ? (size_t)c * 16 : (size_t)TP + (size_t)(c - 512) * 8;
    const int col = h * 128 + 2 * lane;
#pragma unroll
    for (int t = 0; t < 16; ++t) { const size_t off = (row0 + (t < nt ? t : (t & 7))) * D + col;
        in.qv[t] = __builtin_nontemporal_load((const unsigned*)(QS + off)); in.fv[t] = __builtin_nontemporal_load((const unsigned*)(FL + off)); in.vv[t] = __builtin_nontemporal_load((const unsigned*)(VI + off)); }
}
__device__ __forceinline__ void prep_compute(const PrepIn& in, const float* lbl, unsigned char* REC, int c, int h, int lane) {
    const int nt = c < 512 ? 16 : 8;
    const int k0 = 2 * lane, col = h * 128 + k0;
    const f32x2 l0 = *(const f32x2*)(lbl + col), l1 = *(const f32x2*)(lbl + 2048 + col), l2 = *(const f32x2*)(lbl + 4096 + col);
    unsigned char* rec = REC + ((size_t)c * 16 + h) * REC_BYTES;
    float eb[2][16], ki[2][16], bl[2];
#pragma unroll
    for (int e = 0; e < 2; ++e) {
        const float mx = fmaxf(l0[e], fmaxf(l1[e], l2[e])); const float e0 = __expf(l0[e] - mx), e1 = __expf(l1[e] - mx), e2 = __expf(l2[e] - mx);
        const float inv = 1.0f / (e0 + e1 + e2); const float lb = e0 * inv, oml = (e1 + e2) * inv;
        float b = 0.f;
#pragma unroll
        for (int t = 0; t < 16; ++t) { const float ex = __expf(fminf(-(e == 0 ? bf_lo(in.fv[t]) : bf_hi(in.fv[t])), 80.0f));
            const float sg = __builtin_amdgcn_rcpf(1.0f + ex), sgn = ex * sg;
            const float f = lb + oml * sg, kk = oml * sgn;
            if (t < nt) b += __logf(f);
            const float ebt = __expf(b); eb[e][t] = ebt; ki[e][t] = (t < nt) ? kk * __builtin_amdgcn_rcpf(ebt) : 0.f; }
        bl[e] = __expf(b);
    }
    *(f32x2*)(rec + REC_DEC + k0 * 4) = (f32x2){bl[0], bl[1]};
#pragma unroll
    for (int t = 0; t < 16; ++t) { const bool ok = t < nt;
        const unsigned qd = ok ? cvt_pk_bf16(bf_lo(in.qv[t]) * eb[0][t], bf_hi(in.qv[t]) * eb[1][t]) : 0u;
        *(unsigned*)(rec + REC_KI + t * REC_ROW + k0 * 2) = cvt_pk_bf16(ki[0][t], ki[1][t]); *(unsigned*)(rec + REC_QD + t * REC_ROW + k0 * 2) = qd; }
#pragma unroll
    for (int e = 0; e < 2; ++e) { unsigned kw[8], vw[8];
#pragma unroll
        for (int t = 0; t < 16; t += 2) { kw[t >> 1] = cvt_pk_bf16(ki[e][t] * bl[e], ki[e][t + 1] * bl[e]);
            const unsigned a = (t < nt) ? in.vv[t] : 0u, bq = (t + 1 < nt) ? in.vv[t + 1] : 0u;
            vw[t >> 1] = e == 0 ? ((a & 0xffffu) | (bq << 16)) : ((a >> 16) | (bq & 0xffff0000u)); }
        v4u* kp = (v4u*)(rec + REC_KET + (k0 + e) * 32); v4u* vp = (v4u*)(rec + REC_VT + (k0 + e) * 32);
        kp[0] = (v4u){kw[0], kw[1], kw[2], kw[3]}; kp[1] = (v4u){kw[4], kw[5], kw[6], kw[7]};
        vp[0] = (v4u){vw[0], vw[1], vw[2], vw[3]}; vp[1] = (v4u){vw[4], vw[5], vw[6], vw[7]}; }
}

constexpr int GLA_PARTS_OFF = 4 * SLOT_BYTES;
__device__ __forceinline__ void gla_dma(LAS unsigned char* slot, const unsigned char* rec, int npieces, int w, int lane) {
    for (int pc = w; pc < npieces; pc += 8)
        __builtin_amdgcn_global_load_lds((const unsigned*)(rec + pc * 1024 + lane * 16), (LAS unsigned*)(slot + pc * 1024), 16, 0, 0);
}
__device__ __forceinline__ void gla_dma_full(LAS unsigned char* slot, const unsigned char* rec, const bf16* GS, size_t grow0, int h, int ngs, int w, int lane) {
    for (int pc = w; pc < 18 + ngs; pc += 8) {
        if (pc < 18) __builtin_amdgcn_global_load_lds((const unsigned*)(rec + pc * 1024 + lane * 16), (LAS unsigned*)(slot + pc * 1024), 16, 0, 2);
        else __builtin_amdgcn_global_load_lds((const unsigned*)((const unsigned char*)(GS + (grow0 + 4 * (pc - 18) + (lane >> 4)) * D + h * 128) + 16 * (lane & 15)), (LAS unsigned*)(slot + pc * 1024), 16, 0, 2); }
}
__device__ __forceinline__ void gla_state_step(LAS unsigned char* sb, f32x4 (&S)[8], int w, int r, int g) {
    const bf16x8 z8 = (bf16x8){0, 0, 0, 0, 0, 0, 0, 0};
    bf16x8 vb = *(const LAS bf16x8*)(sb + REC_VT + (16 * w + r) * 32 + 16 * (g & 1)); vb = (g < 2) ? vb : z8;
#pragma unroll
    for (int i = 0; i < 8; ++i) {
        bf16x8 ke = *(const LAS bf16x8*)(sb + REC_KET + (16 * i + r) * 32 + 16 * (g & 1)); ke = (g < 2) ? ke : z8;
        const f32x4 dec = *(const LAS f32x4*)(sb + REC_DEC + (16 * i + 4 * g) * 4);
        S[i] = __builtin_amdgcn_mfma_f32_16x16x32_bf16(ke, vb, S[i] * dec, 0, 0, 0);
    }
}
__device__ __forceinline__ f32x4 gla_out_step(LAS unsigned char* sb, const f32x4 (&S)[8], int w, int r, int g) {
    f32x4 AT = (f32x4){0.f, 0.f, 0.f, 0.f};
#pragma unroll
    for (int p = 0; p < 4; ++p) {
        const bf16x8 ka = *(const LAS bf16x8*)(sb + REC_KI + r * REC_ROW + 64 * p + 16 * g), qb = *(const LAS bf16x8*)(sb + REC_QD + r * REC_ROW + 64 * p + 16 * g);
        AT = __builtin_amdgcn_mfma_f32_16x16x32_bf16(ka, qb, AT, 0, 0, 0);
    }
#pragma unroll
    for (int j = 0; j < 4; ++j) AT[j] = (4 * g + j <= r) ? AT[j] : 0.f;
    v4u pw; pw.x = cvt_pk_bf16(AT[0], AT[1]); pw.y = cvt_pk_bf16(AT[2], AT[3]); pw.z = 0u; pw.w = 0u;
    const v2u vlo = *(const LAS v2u*)(sb + REC_VT + (16 * w + r) * 32 + 8 * g);
    v4u vaw; vaw.x = vlo.x; vaw.y = vlo.y; vaw.z = 0u; vaw.w = 0u;
    f32x4 oT = __builtin_amdgcn_mfma_f32_16x16x32_bf16(__builtin_bit_cast(bf16x8, vaw), __builtin_bit_cast(bf16x8, pw), (f32x4){0.f, 0.f, 0.f, 0.f}, 0, 0, 0);
#pragma unroll
    for (int p = 0; p < 4; ++p) {
        v4u sw; sw.x = cvt_pk_bf16(S[2 * p][0], S[2 * p][1]); sw.y = cvt_pk_bf16(S[2 * p][2], S[2 * p][3]); sw.z = cvt_pk_bf16(S[2 * p + 1][0], S[2 * p + 1][1]); sw.w = cvt_pk_bf16(S[2 * p + 1][2], S[2 * p + 1][3]);
        const v2u q0 = *(const LAS v2u*)(sb + REC_QD + r * REC_ROW + 64 * p + 8 * g), q1 = *(const LAS v2u*)(sb + REC_QD + r * REC_ROW + 64 * p + 32 + 8 * g);
        v4u qw; qw.x = q0.x; qw.y = q0.y; qw.z = q1.x; qw.w = q1.y;
        oT = __builtin_amdgcn_mfma_f32_16x16x32_bf16(__builtin_bit_cast(bf16x8, sw), __builtin_bit_cast(bf16x8, qw), oT, 0, 0, 0);
    }
    return oT;
}
__device__ __forceinline__ void gla_gn_store(LAS unsigned char* lds, LAS unsigned char* sb, const f32x4 oT, const f32x4 hgn, bf16* OG, size_t row, bool valid, int h, int w, int r, int g) {
    LAS float* parts = (LAS float*)(lds + GLA_PARTS_OFF);
    float ss = (oT[0] * oT[0] + oT[1] * oT[1]) + (oT[2] * oT[2] + oT[3] * oT[3]);
    ss += __shfl_xor(ss, 16); ss += __shfl_xor(ss, 32);
    if (g == 0) parts[w * 16 + r] = ss;
    asm volatile("s_waitcnt lgkmcnt(0)" ::: "memory"); __builtin_amdgcn_s_barrier(); asm volatile("" ::: "memory");
    float tot = parts[r];
#pragma unroll
    for (int ww = 1; ww < 8; ++ww) tot += parts[ww * 16 + r];
    const float rstd = 1.0f / sqrtf(tot * (1.0f / 128.0f) + EPS);
    const v2u gw = *(const LAS v2u*)(sb + SLOT_GS + r * 256 + (16 * w + 4 * g) * 2);
    const float y0 = oT[0] * rstd * hgn[0] * bf_lo(gw.x), y1 = oT[1] * rstd * hgn[1] * bf_hi(gw.x), y2 = oT[2] * rstd * hgn[2] * bf_lo(gw.y), y3 = oT[3] * rstd * hgn[3] * bf_hi(gw.y);
    v2u o; o.x = cvt_pk_bf16(y0, y1); o.y = cvt_pk_bf16(y2, y3);
    if (valid) *(v2u*)(OG + row * D + h * 128 + 16 * w + 4 * g) = o;
}
#define GLA_WAIT_BAR(n) do { asm volatile("s_waitcnt vmcnt(" #n ")" ::: "memory"); __builtin_amdgcn_s_barrier(); asm volatile("" ::: "memory"); } while (0)
__device__ __forceinline__ void gla_pass_a(LAS unsigned char* lds, const unsigned char* REC, float* SEND, float* DSEG, int b, int h, int seg, int w, int lane) {
    const int r = lane & 15, g = lane >> 4;
    const unsigned char* rec0 = REC + ((size_t)(b * 128 + seg * 32) * 16 + h) * REC_BYTES;
    f32x4 S[8];
#pragma unroll
    for (int i = 0; i < 8; ++i) S[i] = (f32x4){0.f, 0.f, 0.f, 0.f};
    f32x4 Dc = (f32x4){1.f, 1.f, 1.f, 1.f};
#pragma unroll 1
    for (int j = 0; j < 3; ++j) gla_dma(lds + j * SLOT_BYTES, rec0 + (size_t)j * 16 * REC_BYTES, 9, w, lane);
#pragma unroll 1
    for (int ci = 0; ci < 32; ++ci) {
        if (ci < 3) GLA_WAIT_BAR(0); else if (w == 0) GLA_WAIT_BAR(4); else GLA_WAIT_BAR(2);
        const int cn = ci + 3 < 32 ? ci + 3 : 31;
        gla_dma(lds + ((ci + 3) & 3) * SLOT_BYTES, rec0 + (size_t)cn * 16 * REC_BYTES, 9, w, lane);
        LAS unsigned char* sb = lds + (ci & 3) * SLOT_BYTES;
        gla_state_step(sb, S, w, r, g);
        Dc = Dc * *(const LAS f32x4*)(sb + REC_DEC + (16 * w + 4 * g) * 4);
    }
    float* so = SEND + ((size_t)((b * 16 + h) * 3 + seg)) * 16384;
#pragma unroll
    for (int i = 0; i < 8; ++i)
#pragma unroll
        for (int j = 0; j < 4; ++j) so[(size_t)(16 * i + 4 * g + j) * 128 + 16 * w + r] = S[i][j];
    if (r == 0) *(f32x4*)(DSEG + ((size_t)((b * 16 + h) * 4 + seg)) * 128 + 16 * w + 4 * g) = Dc;
    GLA_WAIT_BAR(0);
}
__device__ __forceinline__ void gla_pass_b(LAS unsigned char* lds, const unsigned char* REC, const bf16* GS, const float* SEND, const float* DSEG, const float* hgnorm, bf16* OG, float* Sfinal, int b, int h, int seg, int w, int lane) {
    const int r = lane & 15, g = lane >> 4;
    const unsigned char* rec0 = REC + ((size_t)(b * 128 + seg * 32) * 16 + h) * REC_BYTES;
    const size_t row0 = (size_t)b * SEQ + seg * 512;
#pragma unroll 1
    for (int j = 0; j < 3; ++j) gla_dma_full(lds + j * SLOT_BYTES, rec0 + (size_t)j * 16 * REC_BYTES, GS, row0 + 16 * j, h, 4, w, lane);
    f32x4 S[8];
#pragma unroll
    for (int i = 0; i < 8; ++i) S[i] = (f32x4){0.f, 0.f, 0.f, 0.f};
#pragma unroll 1
    for (int sp = 0; sp < seg; ++sp) {
        const float* e = SEND + ((size_t)((b * 16 + h) * 3 + sp)) * 16384; const float* dsg = DSEG + ((size_t)((b * 16 + h) * 4 + sp)) * 128;
#pragma unroll
        for (int i = 0; i < 8; ++i) { const f32x4 dv = *(const f32x4*)(dsg + 16 * i + 4 * g);
#pragma unroll
            for (int j = 0; j < 4; ++j) S[i][j] = S[i][j] * dv[j] + e[(size_t)(16 * i + 4 * g + j) * 128 + 16 * w + r]; }
    }
    const f32x4 hgn = *(const f32x4*)(hgnorm + 16 * w + 4 * g);
#pragma unroll 1
    for (int ci = 0; ci < 32; ++ci) {
        if (ci < 3) GLA_WAIT_BAR(0); else if (w < 6) GLA_WAIT_BAR(9); else GLA_WAIT_BAR(7);
        const int cn = ci + 3 < 32 ? ci + 3 : 31;
        gla_dma_full(lds + ((ci + 3) & 3) * SLOT_BYTES, rec0 + (size_t)cn * 16 * REC_BYTES, GS, row0 + 16 * cn, h, 4, w, lane);
        LAS unsigned char* sb = lds + (ci & 3) * SLOT_BYTES;
        const f32x4 oT = gla_out_step(sb, S, w, r, g);
        gla_state_step(sb, S, w, r, g);
        gla_gn_store(lds, sb, oT, hgn, OG, row0 + ci * 16 + r, true, h, w, r, g);
    }
    if (seg == 3) {
#pragma unroll
        for (int i = 0; i < 8; ++i)
#pragma unroll
            for (int j = 0; j < 4; ++j) Sfinal[(size_t)(16 * i + 4 * g + j) * 128 + 16 * w + r] = S[i][j];
    }
    GLA_WAIT_BAR(0);
}
__device__ __forceinline__ void gla_sample(LAS unsigned char* lds, const unsigned char* REC, const bf16* GS, const float* S0, float* Sout, const float* hgnorm, bf16* OG, int b, int h, int w, int lane) {
    const int r = lane & 15, g = lane >> 4;
    gla_dma_full(lds, REC + ((size_t)(512 + b) * 16 + h) * REC_BYTES, GS, (size_t)TP + 8 * b, h, 2, w, lane);
    f32x4 S[8];
#pragma unroll
    for (int i = 0; i < 8; ++i)
#pragma unroll
        for (int j = 0; j < 4; ++j) S[i][j] = __builtin_nontemporal_load(S0 + (size_t)(16 * i + 4 * g + j) * 128 + 16 * w + r);
    const f32x4 hgn = *(const f32x4*)(hgnorm + 16 * w + 4 * g);
    GLA_WAIT_BAR(0);
    const f32x4 oT = gla_out_step(lds, S, w, r, g);
    gla_state_step(lds, S, w, r, g);
    gla_gn_store(lds, lds, oT, hgn, OG, (size_t)TP + 8 * b + (r & 7), r < 8, h, w, r, g);
#pragma unroll
    for (int i = 0; i < 8; ++i)
#pragma unroll
        for (int j = 0; j < 4; ++j) __builtin_nontemporal_store(S[i][j], Sout + (size_t)(16 * i + 4 * g + j) * 128 + 16 * w + r);
    GLA_WAIT_BAR(0);
}

constexpr float ATT_SC = 0.044194173824159216f * 1.4426950408889634f;
__device__ __forceinline__ void attn_sample_block(const Frame& F, const float* QSLAB, const float* Kc, const float* Vc, bf16* AO, int b, int h, LAS unsigned char* xl) {
    const int lane = lane_id(), r = lane & 15, g = lane >> 4, w = F.wave;
    LAS float* smax = (LAS float*)xl;
    LAS float* ssum = smax + 64;
    LAS bf16* Pl = (LAS bf16*)(xl + 512);
    const size_t R0 = (size_t)TP + 8 * b;
    const bf16x8 z8 = (bf16x8){0, 0, 0, 0, 0, 0, 0, 0};
    LAS bf16* Ql = (LAS bf16*)F.lds;
    {   const int tq = w * 64 + lane, qr = tq >> 6, qc = (tq & 63) * 8;
        const bf16* sp = (const bf16*)QSLAB + (size_t)(8 * b + qr) * D + h * 512 + qc;
        f32x4 a0, a1; bf8_to_f32(*(const v4u*)sp, a0, a1);
#pragma unroll
        for (int ks = 1; ks < 8; ++ks) { f32x4 x0, x1; bf8_to_f32(*(const v4u*)(sp + (size_t)ks * TS * D), x0, x1); a0 += x0; a1 += x1; }
        v4u qw; qw.x = cvt_pk_bf16(a0[0], a0[1]); qw.y = cvt_pk_bf16(a0[2], a0[3]); qw.z = cvt_pk_bf16(a1[0], a1[1]); qw.w = cvt_pk_bf16(a1[2], a1[3]);
        *(LAS v4u*)(Ql + qr * 520 + qc) = qw; }
    LDS_WAIT(); __syncthreads();
    bf16x8 qB[16];
#pragma unroll
    for (int p = 0; p < 16; ++p) { const bf16x8 t = *(const LAS bf16x8*)(Ql + (r & 7) * 520 + 32 * p + 8 * g); qB[p] = (r < 8) ? t : z8; }
    f32x4 ST[2];
#pragma unroll
    for (int ii = 0; ii < 2; ++ii) {
        const float* kbase = Kc + ((size_t)b * 256 + 32 * w + 16 * ii + r) * D + h * 512 + 8 * g;
        ST[ii] = (f32x4){0.f, 0.f, 0.f, 0.f};
#pragma unroll
        for (int ph = 0; ph < 2; ++ph) {
            f32x4 kv[16];
#pragma unroll
            for (int p = 0; p < 8; ++p) { kv[2 * p] = __builtin_nontemporal_load((const f32x4*)(kbase + 32 * (8 * ph + p))); kv[2 * p + 1] = __builtin_nontemporal_load((const f32x4*)(kbase + 32 * (8 * ph + p) + 4)); }
#pragma unroll
            for (int p = 0; p < 8; ++p) { const f32x4 k0 = kv[2 * p], k1 = kv[2 * p + 1];
                v4u kw; kw.x = cvt_pk_bf16(k0[0], k0[1]); kw.y = cvt_pk_bf16(k0[2], k0[3]); kw.z = cvt_pk_bf16(k1[0], k1[1]); kw.w = cvt_pk_bf16(k1[2], k1[3]);
                ST[ii] = __builtin_amdgcn_mfma_f32_16x16x32_bf16(__builtin_bit_cast(bf16x8, kw), qB[8 * ph + p], ST[ii], 0, 0, 0); }
        }
    }
    ST[0] = ST[0] * ATT_SC; ST[1] = ST[1] * ATT_SC;
    float mloc = fmaxf(fmaxf(fmaxf(ST[0][0], ST[0][1]), fmaxf(ST[0][2], ST[0][3])), fmaxf(fmaxf(ST[1][0], ST[1][1]), fmaxf(ST[1][2], ST[1][3])));
    mloc = fmaxf(mloc, __shfl_xor(mloc, 16)); mloc = fmaxf(mloc, __shfl_xor(mloc, 32));
    if (g == 0 && r < 8) smax[w * 8 + r] = mloc;
    LDS_WAIT(); __syncthreads();
    float M = smax[r & 7];
#pragma unroll
    for (int ww = 1; ww < 8; ++ww) M = fmaxf(M, smax[ww * 8 + (r & 7)]);
    float lsum = 0.f;
#pragma unroll
    for (int ii = 0; ii < 2; ++ii)
#pragma unroll
        for (int j = 0; j < 4; ++j) { ST[ii][j] = __builtin_amdgcn_exp2f(ST[ii][j] - M); lsum += ST[ii][j]; }
    lsum += __shfl_xor(lsum, 16); lsum += __shfl_xor(lsum, 32);
    if (g == 0 && r < 8) ssum[w * 8 + r] = lsum;
    if (r < 8) {
#pragma unroll
        for (int ii = 0; ii < 2; ++ii) { v2u o; o.x = cvt_pk_bf16(ST[ii][0], ST[ii][1]); o.y = cvt_pk_bf16(ST[ii][2], ST[ii][3]); *(LAS v2u*)(Pl + r * 264 + 32 * w + 16 * ii + 4 * g) = o; }
    }
    LDS_WAIT(); __syncthreads();
    f32x4 O0 = (f32x4){0.f, 0.f, 0.f, 0.f}, O1 = O0, O2 = O0, O3 = O0;
    const float* vbase = Vc + ((size_t)b * 256 + 8 * g) * D + h * 512 + 64 * w + 4 * r;
#pragma unroll 2
    for (int p8 = 0; p8 < 8; ++p8) {
        f32x4 vv[8];
#pragma unroll
        for (int j = 0; j < 8; ++j) vv[j] = __builtin_nontemporal_load((const f32x4*)(vbase + (size_t)(32 * p8 + j) * D));
        const bf16x8 pa = *(const LAS bf16x8*)(Pl + (r & 7) * 264 + 32 * p8 + 8 * g);
        v4u b0, b1, b2, b3;
        b0.x = cvt_pk_bf16(vv[0][0], vv[1][0]); b0.y = cvt_pk_bf16(vv[2][0], vv[3][0]); b0.z = cvt_pk_bf16(vv[4][0], vv[5][0]); b0.w = cvt_pk_bf16(vv[6][0], vv[7][0]);
        b1.x = cvt_pk_bf16(vv[0][1], vv[1][1]); b1.y = cvt_pk_bf16(vv[2][1], vv[3][1]); b1.z = cvt_pk_bf16(vv[4][1], vv[5][1]); b1.w = cvt_pk_bf16(vv[6][1], vv[7][1]);
        b2.x = cvt_pk_bf16(vv[0][2], vv[1][2]); b2.y = cvt_pk_bf16(vv[2][2], vv[3][2]); b2.z = cvt_pk_bf16(vv[4][2], vv[5][2]); b2.w = cvt_pk_bf16(vv[6][2], vv[7][2]);
        b3.x = cvt_pk_bf16(vv[0][3], vv[1][3]); b3.y = cvt_pk_bf16(vv[2][3], vv[3][3]); b3.z = cvt_pk_bf16(vv[4][3], vv[5][3]); b3.w = cvt_pk_bf16(vv[6][3], vv[7][3]);
        O0 = __builtin_amdgcn_mfma_f32_16x16x32_bf16(pa, __builtin_bit_cast(bf16x8, b0), O0, 0, 0, 0);
        O1 = __builtin_amdgcn_mfma_f32_16x16x32_bf16(pa, __builtin_bit_cast(bf16x8, b1), O1, 0, 0, 0);
        O2 = __builtin_amdgcn_mfma_f32_16x16x32_bf16(pa, __builtin_bit_cast(bf16x8, b2), O2, 0, 0, 0);
        O3 = __builtin_amdgcn_mfma_f32_16x16x32_bf16(pa, __builtin_bit_cast(bf16x8, b3), O3, 0, 0, 0);
    }
    if (g < 2) {
#pragma unroll
        for (int j = 0; j < 4; ++j) { const int q = 4 * g + j; float tot = ssum[q];
#pragma unroll
            for (int ww = 1; ww < 8; ++ww) tot += ssum[ww * 8 + q];
            const float inv = 1.0f / tot;
            v2u o; o.x = cvt_pk_bf16(O0[j] * inv, O1[j] * inv); o.y = cvt_pk_bf16(O2[j] * inv, O3[j] * inv);
            *(v2u*)(AO + (R0 + q) * D + h * 512 + 64 * w + 4 * r) = o; }
    }
    LDS_WAIT(); __syncthreads();
}
__device__ __forceinline__ f32x4 ld4bf(const GAS bf16* p) { const v2u w = *(const GAS v2u*)p; return (f32x4){bf_lo(w.x), bf_hi(w.x), bf_lo(w.y), bf_hi(w.y)}; }
template <int W, bool SMP>
__device__ __forceinline__ void pool_unit(const bf16* U, const bf16* SL, const float* spool, bf16* POOLED, int run, int j, int lane_) {
    constexpr int NOUT = 8, NR = NOUT + W - 1;
    const int col = 4 * opq(lane_) + 256 * j;
    f32x4 rows[NR];
    if constexpr (SMP) { const int b = run;
        const GAS float* cp = (const GAS float*)(unsigned long long)(spool + (size_t)(b * 15 + 15 - (W - 1)) * D + col);
#pragma unroll
        for (int i = 0; i < W - 1; ++i) { rows[i] = *(const GAS f32x4*)cp; cp += D; asm volatile("" : "+v"(cp)); }
#pragma unroll
        for (int i = W - 1; i < NR; ++i) rows[i] = (f32x4){0.f, 0.f, 0.f, 0.f};
        const GAS bf16* sp = (const GAS bf16*)(unsigned long long)(SL + (size_t)(8 * b) * D + col);
#pragma unroll 1
        for (int ks = 0; ks < 8; ++ks) { const GAS bf16* q = sp;
#pragma unroll
            for (int i = W - 1; i < NR; ++i) { rows[i] += ld4bf(q); q += D; asm volatile("" : "+v"(q)); }
            sp += (size_t)TS * D; }
    } else { const int t0 = (run & 255) * 8; const bf16* ub = U + (size_t)(run >> 8) * SEQ * D;
        const GAS bf16* q = (const GAS bf16*)(unsigned long long)(ub + (long)(t0 - (W - 1)) * D + col);
#pragma unroll
        for (int i = 0; i < NR; ++i) { const int tt = t0 - (W - 1) + i; rows[i] = (f32x4){0.f, 0.f, 0.f, 0.f}; if (tt >= 0) rows[i] = ld4bf(q); q += D; asm volatile("" : "+v"(q)); }
    }
    const size_t grow0 = SMP ? (size_t)TP + 8 * run : (size_t)run * 8;
#pragma unroll
    for (int o = 0; o < NOUT; ++o) { f32x4 acc = rows[W - 1 + o];
#pragma unroll
        for (int d = 1; d < W; ++d) acc += rows[W - 1 + o - d];
        float cnt = (float)W; if (!SMP) { const int t = (run & 255) * 8 + o; cnt = (float)((t + 1) < W ? (t + 1) : W); }
        const f32x4 y = acc / cnt - rows[W - 1 + o];
        v2u ov; ov.x = cvt_pk_bf16(y[0], y[1]); ov.y = cvt_pk_bf16(y[2], y[3]); *(v2u*)(POOLED + (grow0 + o) * D + col) = ov; }
}

__global__ void __launch_bounds__(NTHR, 2) fwd(Args args) {
    extern __shared__ __attribute__((aligned(16))) unsigned char lds_raw[];
    Frame F;
    F.lds = (LAS unsigned char*)lds_raw; F.ws = args.ws; F.out = args.out;
    F.wave = __builtin_amdgcn_readfirstlane(threadIdx.x >> 6);
    F.G = gridDim.x; F.gw = blockIdx.x * NWAVES + F.wave; F.ngw = F.G * NWAVES;
    volatile LAS unsigned* MISC = (volatile LAS unsigned*)(F.lds + MISC_OFF);
    if (threadIdx.x < 64) MISC[threadIdx.x] = 0u;
    __syncthreads();
    unsigned* ctl = (unsigned*)(args.ws + WS_CTL);
    XcdBarrier bar; bar.bar = ctl + CW_BAR; bar.x = 0; bar.st = nullptr;
#if !MK_SPLIT
    bar = xcd_barrier_post(ctl + CW_BAR, MISC + 8);
#define GRID_BAR() do { XcdBarrier b_ = bar; b_.bar = (unsigned*)opq_p((unsigned char*)b_.bar); xcd_barrier(b_, opq_s(F.wave) == 0 && lane_id() == 0); } while (0)
#else
#define GRID_BAR() do {} while (0)
#endif
    const int lo = args.ph_lo, hi = args.ph_hi;
#define IN(k) (lo <= (k) && (k) < hi)
#define BOTH(k) (IN(k) && IN((k) + 1))
#define PHASE_PTRS() unsigned char* ws = opq_p(args.ws); bf16* HN = (bf16*)(ws + WS_HN); bf16* MEMN = (bf16*)(ws + WS_MEMN); float* X = (float*)opq_p((unsigned char*)args.out) + O_Y; \
    float* Mb = (float*)(ws + WS_M); bf16* Qb = (bf16*)(ws + WS_Q); bf16* AO = (bf16*)(ws + WS_AO); bf16* Hb = (bf16*)(ws + WS_H); float* U = (float*)(ws + WS_U); \
    (void)HN; (void)MEMN; (void)X; (void)Mb; (void)Qb; (void)AO; (void)Hb; (void)U;

    for (int rep_ = 0; rep_ < PROBE_P0; ++rep_) if (IN(0)) { PHASE_PTRS();
        int it = 0;
        for (int l = 0; l < 2; ++l) it = tr_matrix(F, as_global(args.in[17]) + (size_t)l * D * 4096, D, 4096, 4096, (bf16*)(ws + WS_WXKV) + (size_t)l * 4096 * D, D, it);
        it = tr_matrix(F, as_global(args.in[7]), D, NPROJ, NPROJ, (bf16*)(ws + WS_WINA), D, it, as_global(args.in[19]));
        it = tr_matrix(F, as_global(args.in[10]), D, D, D, (bf16*)(ws + WS_WOUTA), D, it);
        it = tr_matrix(F, as_global(args.in[11]), D, D, D, (bf16*)(ws + WS_WINB), D, it, as_global(args.in[19]) + D);
        for (int l = 0; l < 2; ++l) {
            const float* wq_ = as_global(args.in[16]) + (size_t)l * D * D; const float* nx = as_global(args.in[21]) + l * D; bf16* dq = (bf16*)(ws + WS_WXQN) + (size_t)l * D * D;
            for (size_t i = ((size_t)blockIdx.x * NTHR + F.wave * 64 + lane_id()) * 4; i < (size_t)D * D; i += (size_t)F.G * NTHR * 4) {
                const f32x4 v = *(const f32x4*)(wq_ + i) * nx[i >> 11]; v2u o; o.x = cvt_pk_bf16(v[0], v[1]); o.y = cvt_pk_bf16(v[2], v[3]); *(v2u*)(dq + i) = o; } }
        {   const float* pw = as_global(args.in[12]); const float* psc = as_global(args.in[13]); bf16* wps = (bf16*)(ws + WS_WPOOL);
            for (size_t i = ((size_t)blockIdx.x * NTHR + F.wave * 64 + lane_id()) * 4; i < (size_t)4 * 512 * 512; i += (size_t)F.G * NTHR * 4) {
                const f32x4 v = *(const f32x4*)(pw + i) * *(const f32x4*)(psc + (i >> 18) * 512 + (i & 511)); v2u o; o.x = cvt_pk_bf16(v[0], v[1]); o.y = cvt_pk_bf16(v[2], v[3]); *(v2u*)(wps + i) = o; } }
        it = tr_matrix(F, as_global(args.in[14]), D, D, D, (bf16*)(ws + WS_WOUTB), D, it);
        for (int l = 0; l < 2; ++l) {
            it = tr_matrix(F, as_global(args.in[16]) + (size_t)l * D * D, D, D, D, (bf16*)(ws + WS_WXQ) + (size_t)l * D * D, D, it, as_global(args.in[21]) + l * D);
            it = tr_matrix(F, as_global(args.in[18]) + (size_t)l * D * D, D, D, D, (bf16*)(ws + WS_WXO) + (size_t)l * D * D, D, it);
            it = tr_matrix(F, as_global(args.in[25]) + (size_t)l * D * FF, D, FF, FF, (bf16*)(ws + WS_WUP) + (size_t)l * D * FF, D, it, as_global(args.in[23]) + l * D);
            it = tr_matrix(F, as_global(args.in[26]) + (size_t)l * D * FF, FF, D, D, (bf16*)(ws + WS_WDOWN) + (size_t)l * D * FF, FF, it);
        }
        for (int row = F.gw; row < MT; row += F.ngw) {
            const float* xr = row < TP ? as_global(args.in[0]) + (size_t)row * D : as_global(args.in[1]) + (size_t)(row - TP) * D;
            {   const int lane = lane_id(); f32x4 v[8]; float ss = 0.f; bf16* xb = (bf16*)(ws + WS_XB) + (size_t)row * D;
#pragma unroll
                for (int j = 0; j < 8; ++j) { v[j] = *(const f32x4*)(xr + 4 * lane + 256 * j); ss += (v[j][0] * v[j][0] + v[j][1] * v[j][1]) + (v[j][2] * v[j][2] + v[j][3] * v[j][3]);
                    v2u o; o.x = cvt_pk_bf16(v[j][0], v[j][1]); o.y = cvt_pk_bf16(v[j][2], v[j][3]); *(v2u*)(xb + 4 * lane + 256 * j) = o; }
                const float r = 1.0f / sqrtf(wave_sum(ss) * (1.0f / D) + EPS); if (lane == 0) ((float*)(ws + WS_RS))[row] = r; }
        }
        for (int r2 = F.gw; r2 < 2048; r2 += F.ngw) { const int l = r2 >> 10, row = r2 & 1023;
            norm_row(as_global(args.in[6]) + (size_t)row * D, as_global(args.in[15]) + (size_t)l * D, MEMN + ((size_t)l * 1024 + row) * D, nullptr, lane_id()); }
        if (BOTH(0) && rep_ == PROBE_P0 - 1) GRID_BAR();
    }
    for (int rep_ = 0; rep_ < PROBE_G1; ++rep_) if (IN(1)) { PHASE_PTRS();
        pg8::SchedP1 S{(const char*)(ws + WS_XB), (const char*)(ws + WS_WINA), (char*)(ws + WS_QS), (char*)(ws + WS_FL), (char*)(ws + WS_VI), (char*)(ws + WS_GS), (const char*)MEMN, (const char*)(ws + WS_WXKV), (char*)(as_global(args.out) + O_KP), (char*)(as_global(args.out) + O_VP), (char*)(ws + WS_KPB), (char*)(ws + WS_VPB), F.G, (int)blockIdx.x};
        pg8::EpiP1 E{(const float*)(ws + WS_RS)};
        pg8::gemm_phase<pg8::EpiP1, pg8::SchedP1>(F.lds, F.wave, D, D, D, S, E);
        if (BOTH(1) && rep_ == PROBE_G1 - 1) GRID_BAR();
    }
    if (IN(2)) { PHASE_PTRS();
        {   const bf16* QSp = (const bf16*)(ws + WS_QS); const bf16* FLp = (const bf16*)(ws + WS_FL); const bf16* VIp = (const bf16*)(ws + WS_VI); const bf16* GSp = (const bf16*)(ws + WS_GS);
            const int lane = lane_id(); int u = F.gw; PrepIn cur, nxt;
            if (u < NCHUNK * HH) prep_load(cur, QSp, FLp, VIp, GSp, u >> 4, u & 15, lane);
#pragma unroll 1
            while (u < NCHUNK * HH) { const int un = u + F.ngw;
                if (un < NCHUNK * HH) prep_load(nxt, QSp, FLp, VIp, GSp, un >> 4, un & 15, lane);
                prep_compute(cur, as_global(args.in[8]), ws + WS_REC, u >> 4, u & 15, lane);
                cur = nxt; u = un; }
        }
        {   const int wl = (F.G == 256 && blockIdx.x >= 128) ? 1 : 0;
            pg8::SchedWK S{(const char*)(ws + WS_KPB + (size_t)wl * 1024 * D * 2), (const char*)(ws + WS_WXQN + (size_t)wl * D * D * 2), (char*)(ws + (wl ? WS_WKT1 : WS_WKT)), F.G, (int)blockIdx.x, wl * 128}; pg8::EpiBf16<0> E{nullptr};
            pg8::gemm_phase<pg8::EpiBf16<0>, pg8::SchedWK, true>(F.lds, F.wave, D, D, 512, S, E); }
        if (BOTH(2)) GRID_BAR();
    }
    if (IN(3)) { PHASE_PTRS();
        const int lane = lane_id(), w = opq_s(F.wave);
        for (int u = blockIdx.x; u < 256; u += F.G) { const int seg = u & 3, bh = u >> 2;
            if (seg < 3) gla_pass_a(F.lds, ws + WS_REC, (float*)(ws + WS_SEND), (float*)(ws + WS_DSEG), bh >> 4, bh & 15, seg, w, lane); }
        {   pg8::SchedWP S{(const char*)(ws + WS_WOUTB), (const char*)(ws + WS_WPOOL), (char*)(ws + WS_MIXED), F.G, (int)blockIdx.x}; pg8::EpiBf16<0> E{nullptr};
            pg8::gemm_phase<pg8::EpiBf16<0>, pg8::SchedWP, true>(F.lds, F.wave, D, 512, 512, S, E); }
        for (int su = blockIdx.x; su < DB * HH; su += F.G) { const int b = su >> 4, h = su & 15;
            gla_sample(F.lds, ws + WS_REC, (const bf16*)(ws + WS_GS), as_global(args.in[2]) + (size_t)su * 16384, as_global(args.out) + O_SHS + (size_t)su * 16384, as_global(args.in[9]), (bf16*)(ws + WS_OG), b, h, w, lane); }
        if (BOTH(3)) GRID_BAR();
    }
    if (IN(4)) { PHASE_PTRS();
        const int lane = lane_id(), w = opq_s(F.wave);
        for (int u = blockIdx.x; u < 256; u += F.G) { const int seg = u & 3, bh = u >> 2;
            gla_pass_b(F.lds, ws + WS_REC, (const bf16*)(ws + WS_GS), (const float*)(ws + WS_SEND), (const float*)(ws + WS_DSEG), as_global(args.in[9]), (bf16*)(ws + WS_OG), as_global(args.out) + O_SHP + (size_t)bh * 16384, bh >> 4, bh & 15, seg, w, lane); }
        if (BOTH(4)) GRID_BAR();
    }
#define SCHED_G(Ap, lda_, Bp, ldb_, Cp, ldc_, nN_, csz_, gsh_, gkb_) pg8::SchedG{(const char*)(Ap), (const char*)(Bp), (char*)(Cp), lda_, ldb_, ldc_, 36, nN_, csz_, F.G, (int)blockIdx.x, gsh_, gkb_}
    if (IN(5)) { PHASE_PTRS();
        pg8::SchedGS S{(const char*)(ws + WS_OG), (const char*)(ws + WS_WOUTA), (char*)Mb, (char*)(ws + WS_SLAB), D, D, D, 2, F.G, (int)blockIdx.x, 2}; pg8::EpiBf16<0> E{nullptr};
        pg8::gemm_phase<pg8::EpiBf16<0>, pg8::SchedGS, false, true>(F.lds, F.wave, D, D, D, S, E);
        if (BOTH(5)) GRID_BAR();
    }
#pragma unroll
    for (int l = 0; l < 2; ++l) {
        const int base = 6 + 12 * l;
        if (l == 1) {
            if (IN(14)) { PHASE_PTRS();
                pg8::SchedGS S{(const char*)(ws + WS_XB), (const char*)(ws + WS_WINB), (char*)U, (char*)(ws + WS_SLAB), D, D, D, 2, F.G, (int)blockIdx.x, 2}; pg8::EpiBf16<0> E{(const float*)(ws + WS_RS)};
                pg8::gemm_phase<pg8::EpiBf16<0>, pg8::SchedGS, false, true>(F.lds, F.wave, D, D, D, S, E);
                if (BOTH(14)) GRID_BAR();
            }
            if (IN(15)) { PHASE_PTRS();
                bf16* POOLED = (bf16*)(ws + WS_POOLED); const bf16* SL = (const bf16*)(ws + WS_SLAB); const bf16* Ub = (const bf16*)U; const int lane = lane_id();
                const bool deal = F.ngw == 2048; const int gwp = F.gw; const int nun = deal ? (gwp < 1024 ? 4 : 5) : (gwp < 1152 * 8 ? (1152 * 8 - gwp + F.ngw - 1) / F.ngw : 0);
                for (int k = 0; k < nun; ++k) { const int u = deal ? (gwp < 1024 ? (k == 0 ? 8192 + gwp : 3 * gwp + k - 1) : 3072 + 5 * (gwp - 1024) + k) : gwp + k * F.ngw; const int run = u >> 3, j = u & 7;
                    if (run < 1024) { switch (j >> 1) { case 0: pool_unit<2, false>(Ub, SL, as_global(args.in[3]), POOLED, run, j, lane); break; case 1: pool_unit<4, false>(Ub, SL, as_global(args.in[3]), POOLED, run, j, lane); break;
                                                       case 2: pool_unit<8, false>(Ub, SL, as_global(args.in[3]), POOLED, run, j, lane); break; default: pool_unit<16, false>(Ub, SL, as_global(args.in[3]), POOLED, run, j, lane); break; } }
                    else { switch (j >> 1) { case 0: pool_unit<2, true>(Ub, SL, as_global(args.in[3]), POOLED, run - 1024, j, lane); break; case 1: pool_unit<4, true>(Ub, SL, as_global(args.in[3]), POOLED, run - 1024, j, lane); break;
                                             case 2: pool_unit<8, true>(Ub, SL, as_global(args.in[3]), POOLED, run - 1024, j, lane); break; default: pool_unit<16, true>(Ub, SL, as_global(args.in[3]), POOLED, run - 1024, j, lane); break; } } }
                for (int rr = F.gw; rr < (NB + DB) * 15; rr += F.ngw) {
                    if (rr < NB * 15) { const int b = rr / 15, i = rr % 15; const bf16* src = Ub + (size_t)(b * SEQ + SEQ - 15 + i) * D; float* dst = as_global(args.out) + O_SPP + (size_t)rr * D;
#pragma unroll
                        for (int j = 0; j < 8; ++j) *(f32x4*)(dst + 4 * lane + 256 * j) = ld4bf((const GAS bf16*)(unsigned long long)(src + 4 * lane + 256 * j)); }
                    else { const int q = rr - NB * 15, b = q / 15, i = q % 15; float* dst = as_global(args.out) + O_SPS + (size_t)q * D;
                        if (i < 7) { const float* src = as_global(args.in[3]) + (size_t)(b * 15 + 8 + i) * D;
#pragma unroll
                            for (int j = 0; j < 8; ++j) *(f32x4*)(dst + 4 * lane + 256 * j) = *(const f32x4*)(src + 4 * lane + 256 * j); }
                        else { const bf16* sr = SL + (size_t)(8 * b + (i - 7)) * D + 4 * lane;
#pragma unroll
                            for (int j = 0; j < 8; ++j) { f32x4 a = ld4bf((const GAS bf16*)(unsigned long long)(sr + 256 * j));
#pragma unroll
                                for (int ks = 1; ks < 8; ++ks) a += ld4bf((const GAS bf16*)(unsigned long long)(sr + (size_t)ks * TS * D + 256 * j));
                                *(f32x4*)(dst + 4 * lane + 256 * j) = a; } } }
                }
                if (BOTH(15)) GRID_BAR();
            }
            if (IN(17)) { PHASE_PTRS();
                pg8::SchedGS S{(const char*)(ws + WS_POOLED), (const char*)(ws + WS_MIXED), (char*)Mb, (char*)(ws + WS_SLAB), D, D, D, 2, F.G, (int)blockIdx.x, 2}; pg8::EpiBf16<0> E{nullptr};
                pg8::gemm_phase<pg8::EpiBf16<0>, pg8::SchedGS, false, true>(F.lds, F.wave, D, D, D, S, E);
                if (BOTH(17)) GRID_BAR();
            }
        }
        if (IN(base + 0)) { PHASE_PTRS(); t_phase(F, (const bf16*)Mb, (const float*)(ws + WS_SLAB), (bf16*)(ws + WS_XB), nullptr, as_global(args.in[20]) + l * D, (float*)(ws + WS_RS), l == 0 ? as_global(args.in[0]) : nullptr, l == 0 ? as_global(args.in[1]) : nullptr); if (BOTH(base + 0)) GRID_BAR(); }
        if (IN(base + 1)) { PHASE_PTRS();
            LAS unsigned char* xl = F.lds + RING_BYTES;
            {   pg8::SchedS S{(const char*)(ws + WS_XB), (const char*)(ws + (l ? WS_WKT1 : WS_WKT)), (char*)(ws + WS_P), F.G, (int)blockIdx.x}; pg8::EpiSoftmax E{xl + 5120, (const float*)(ws + WS_RS)};
                pg8::gemm_phase<pg8::EpiSoftmax, pg8::SchedS>(F.lds, F.wave, D, D, D, S, E); }
            {   pg8::SchedXQS S{(const char*)(ws + WS_XB), (const char*)(ws + WS_WXQ + (size_t)l * D * D * 2), (char*)(ws + WS_SLAB), F.G, (int)blockIdx.x}; pg8::EpiBf16<0> E{(const float*)(ws + WS_RS)};
                pg8::gemm_phase<pg8::EpiBf16<0>, pg8::SchedXQS, false, true>(F.lds, F.wave, D, D, D, S, E); }
            {   pg8::SchedAtt1V S{nullptr, nullptr, nullptr, (const char*)(ws + WS_WXO + (size_t)l * D * D * 2), (const char*)(ws + WS_VPB + (size_t)l * 1024 * D * 2), (char*)(ws + WS_VWT), F.G, (int)blockIdx.x, 1}; pg8::EpiBf16<0> E{nullptr};
                pg8::gemm_phase<pg8::EpiBf16<0>, pg8::SchedAtt1V, true>(F.lds, F.wave, D, D, 512, S, E); }
            if (BOTH(base + 1)) GRID_BAR();
        }
        for (int rep_ = 0; rep_ < PROBE_ATT; ++rep_) if (IN(base + 2)) { PHASE_PTRS();
            LAS unsigned char* xl = F.lds + RING_BYTES;
            for (int su = blockIdx.x; su < DB * MH; su += F.G)
                attn_sample_block(F, (const float*)(ws + WS_SLAB), as_global(args.in[4]) + (size_t)l * DB * NMEM * D, as_global(args.in[5]) + (size_t)l * DB * NMEM * D, AO, su >> 2, su & 3, xl);
            if (BOTH(base + 2) && rep_ == PROBE_ATT - 1) GRID_BAR();
        }
        if (IN(base + 3)) { PHASE_PTRS();
            pg8::SchedXO S{(const char*)(ws + WS_P), (const char*)(ws + WS_VWT), (char*)Mb, (const char*)AO, (const char*)(ws + WS_WXO + (size_t)l * D * D * 2), (char*)(ws + WS_SLAB), F.G, (int)blockIdx.x}; pg8::EpiBf16<0> E{nullptr};
            pg8::gemm_phase<pg8::EpiBf16<0>, pg8::SchedXO, false, true, true>(F.lds, F.wave, 1024, 1024, D, S, E);
            if (BOTH(base + 3)) GRID_BAR();
        }
        if (IN(base + 4)) { PHASE_PTRS(); t_phase(F, (const bf16*)Mb, (const float*)(ws + WS_SLAB), (bf16*)(ws + WS_XB), nullptr, as_global(args.in[22]) + l * D, (float*)(ws + WS_RS)); if (BOTH(base + 4)) GRID_BAR(); }
        if (IN(base + 5)) { PHASE_PTRS();
            unsigned* flag = (unsigned*)ws + CW_FLAG + 64 * l;
            pg8::SchedUP S{(const char*)(ws + WS_XB), (const char*)(ws + WS_WUP + (size_t)l * D * FF * 2), (char*)Hb, F.G, (int)blockIdx.x, flag}; pg8::EpiBf16<1> E{(const float*)(ws + WS_RS)};
            pg8::gemm_phase<pg8::EpiBf16<1>, pg8::SchedUP, false, false, false, true>(F.lds, F.wave, D, D, D, S, E);
            if (F.G == 256 && blockIdx.x >= 128) {
                if (opq_s(F.wave) == 0 && lane_id() == 0) { XB_SPIN(xb_ld(flag) < 128u, (unsigned*)ws + CW_BAR); __builtin_amdgcn_fence(__ATOMIC_ACQUIRE, "agent"); }
                __syncthreads();
                pg8::SchedDS S2{(const char*)Hb, (const char*)(ws + WS_WDOWN + (size_t)l * D * FF * 2), (char*)(ws + WS_SLAB), (int)blockIdx.x}; pg8::EpiBf16<0> E2{nullptr};
                pg8::gemm_phase<pg8::EpiBf16<0>, pg8::SchedDS, false, true>(F.lds, F.wave, FF, FF, FF, S2, E2); }
            if (BOTH(base + 5)) GRID_BAR();
        }
        if (IN(base + 6)) { PHASE_PTRS();
            pg8::SchedGS S{(const char*)Hb, (const char*)(ws + WS_WDOWN + (size_t)l * D * FF * 2), (char*)Mb, (char*)(ws + WS_SLAB), FF, FF, FF, 2, F.G, (int)blockIdx.x, 2, F.G == 256 ? 256 : 512}; pg8::EpiBf16<0> E{nullptr};
            pg8::gemm_phase<pg8::EpiBf16<0>, pg8::SchedGS, false, true>(F.lds, F.wave, FF, FF, FF, S, E);
            if (BOTH(base + 6)) GRID_BAR();
        }
        if (IN(base + 7)) { PHASE_PTRS(); t_phase(F, (const bf16*)Mb, (const float*)(ws + WS_SLAB), (bf16*)(ws + WS_XB), l == 1 ? X : nullptr, as_global(args.in[24]) + l * D, l == 0 ? (float*)(ws + WS_RS) : nullptr); if (BOTH(base + 7)) GRID_BAR(); }
    }
#if MK_LAST_PHASE < 25
    {   const size_t i0 = (size_t)blockIdx.x * NTHR + F.wave * 64 + lane_id(), st = (size_t)F.G * NTHR;
        if (MK_LAST_PHASE < 3) { for (size_t i = i0; i < O_SPP - O_SHP; i += st) args.out[O_SHP + i] = 0.f; for (size_t i = i0; i < O_SPS - O_SHS; i += st) args.out[O_SHS + i] = 0.f; }
        if (MK_LAST_PHASE < 15) { for (size_t i = i0; i < O_KP - O_SPP; i += st) args.out[O_SPP + i] = 0.f; for (size_t i = i0; i < O_END - O_SPS; i += st) args.out[O_SPS + i] = 0.f; }
    }
#endif
#undef IN
#undef BOTH
}

extern "C" void kernel_launch(void* const* d_in, const int* in_sizes, int n_in, void* d_out, int out_size, void* d_ws, size_t ws_size, hipStream_t stream) {
    static int grid = 0;
    if (grid == 0) {
        if (n_in != 27 || (size_t)out_size != O_END || ws_size < WS_END) { fprintf(stderr, "kernel_launch: unexpected shapes: n_in %d out %d ws %zu\n", n_in, out_size, ws_size); grid = -1; return; }
        int dev = 0, cus = 0, per_cu = 0;
        if (hipGetDevice(&dev) != hipSuccess || hipDeviceGetAttribute(&cus, hipDeviceAttributeMultiprocessorCount, dev) != hipSuccess) { grid = -1; return; }
        if (hipFuncSetAttribute((const void*)fwd, hipFuncAttributeMaxDynamicSharedMemorySize, LDS_BYTES) != hipSuccess) { fprintf(stderr, "kernel_launch: hipFuncSetAttribute failed\n"); grid = -1; return; }
        if (hipOccupancyMaxActiveBlocksPerMultiprocessor(&per_cu, (const void*)fwd, NTHR, LDS_BYTES) != hipSuccess || per_cu < 1) fprintf(stderr, "kernel_launch: occupancy query reports %d\n", per_cu);
        (void)hipGetLastError();
        grid = cus;
    }
    if (grid < 0) return;
    (void)hipMemsetAsync((char*)d_ws + WS_CTL, 0, CTL_ZERO_BYTES, stream);
    Args a{};
    for (int i = 0; i < 27; ++i) a.in[i] = (const float*)d_in[i];
    a.out = (float*)d_out; a.ws = (unsigned char*)d_ws;
    const int last = MK_LAST_PHASE + 1;
#if MK_SPLIT
    for (int p = 0; p < last; ++p) { a.ph_lo = p; a.ph_hi = p + 1; hipLaunchKernelGGL(fwd, dim3(grid), dim3(NTHR), LDS_BYTES, stream, a); }
#else
    a.ph_lo = 0; a.ph_hi = last;
    hipLaunchKernelGGL(fwd, dim3(grid), dim3(NTHR), LDS_BYTES, stream, a);
#endif
}
```

```cpp
#include <hip/hip_runtime.h>
#include <cstdio>
#include <cstdint>

#ifndef MK_SPLIT
#define MK_SPLIT 0
#endif
#ifndef MK_LAST_PHASE
#define MK_LAST_PHASE 25
#endif

#define BRINGUP_SCALE 1.0f
#ifndef PROBE_ATT
#define PROBE_ATT 1
#endif
#ifndef PROBE_P0
#define PROBE_P0 1
#endif
#ifndef PROBE_G1
#define PROBE_G1 1
#endif
#ifndef PROBE_GLA
#define PROBE_GLA 1
#endif
#define GAS __attribute__((address_space(1)))
#define LAS __attribute__((address_space(3)))
typedef unsigned short bf16;
typedef unsigned v4u __attribute__((ext_vector_type(4)));
typedef unsigned v2u __attribute__((ext_vector_type(2)));
typedef float f32x4 __attribute__((ext_vector_type(4)));
typedef float f32x2 __attribute__((ext_vector_type(2)));
typedef short bf16x8 __attribute__((ext_vector_type(8)));
typedef short bf16x4 __attribute__((ext_vector_type(4)));

constexpr int D = 2048, FF = 8192, NPROJ = 8192;
constexpr int TP = 8192, TS = 1024, MT = 9216;
constexpr int SEQ = 2048, NB = 4, DB = 128, DSQ = 8;
constexpr int NMEM = 256, MH = 4, MHD = 512;
constexpr int HH = 16, DK = 128, DV = 128;
constexpr int NCHUNK = 640;
constexpr float EPS = 1e-6f;
constexpr int NWAVES = 8, NTHR = 512;

constexpr size_t O_Y = 0, O_SHP = 18874368, O_SPP = 19922944, O_KP = 20045824, O_VP = 24240128, O_SHS = 28434432, O_SPS = 61988864, O_END = 65921024;

constexpr size_t MiB = 1u << 20;
constexpr size_t WS_CTL = 0, CTL_ZERO_BYTES = 1 * MiB;
constexpr size_t WS_WINA = 2 * MiB, WS_WOUTA = 34 * MiB, WS_WINB = 42 * MiB, WS_WPOOL = 50 * MiB, WS_WOUTB = 52 * MiB, WS_WXQ = 60 * MiB, WS_WXO = 76 * MiB,
                 WS_WXKV = 92 * MiB, WS_WUP = 124 * MiB, WS_WDOWN = 188 * MiB;
constexpr size_t WS_HN = 256 * MiB;
constexpr size_t WS_MEMN = 292 * MiB;
constexpr size_t WS_KPB = 300 * MiB;
constexpr size_t WS_VPT = 308 * MiB;
constexpr size_t WS_PROJ = 320 * MiB;
constexpr size_t WS_H = 320 * MiB;
constexpr size_t WS_QD = 608 * MiB, WS_KI = 648 * MiB, WS_KET = 688 * MiB, WS_VT = 728 * MiB, WS_DEC = 768 * MiB;
constexpr size_t WS_M = 776 * MiB;
constexpr size_t WS_Q = 848 * MiB;
constexpr size_t WS_AO = 884 * MiB;
constexpr size_t WS_OG = 920 * MiB;
constexpr size_t WS_POOLED = 956 * MiB;
constexpr size_t WS_MIXED = 992 * MiB;
constexpr size_t WS_U = 1028 * MiB;
constexpr size_t WS_P = 1100 * MiB;
constexpr size_t WS_QS = 320 * MiB, WS_VI = 356 * MiB, WS_GS = 392 * MiB, WS_FL = 428 * MiB;
constexpr size_t WS_REC = 1116 * MiB;
constexpr size_t WS_SEND = 1336 * MiB;
constexpr size_t WS_DSEG = 1348 * MiB;
constexpr size_t WS_SLAB = 1352 * MiB;
constexpr size_t WS_VPB = 1416 * MiB;
constexpr size_t WS_VWT = 1424 * MiB;
constexpr size_t WS_XB = 1440 * MiB;
constexpr size_t WS_RS = 1476 * MiB;
constexpr size_t WS_WXQN = 1477 * MiB;
constexpr size_t WS_WKT1 = 256 * MiB;
constexpr size_t WS_WKT = 1493 * MiB;
constexpr size_t WS_END = 1509 * MiB;
constexpr int REC_BYTES = 18432, REC_DEC = 0, REC_KET = 1024, REC_VT = 5120, REC_KI = 9216, REC_QD = 13568, REC_ROW = 272;
constexpr int SLOT_BYTES = 22528, SLOT_GS = 18432;
constexpr int CW_BAR = 4096;

constexpr int RING_BYTES = 131072;
constexpr int LDS_BYTES = 147456;
constexpr int MISC_OFF = LDS_BYTES - 256;

#define LDS_WAIT() asm volatile("s_waitcnt lgkmcnt(0)" ::: "memory")
#define VM_WAIT() asm volatile("s_waitcnt vmcnt(0)" ::: "memory")
__device__ __forceinline__ unsigned cvt_pk_bf16(float lo, float hi) { unsigned r; asm volatile("v_cvt_pk_bf16_f32 %0, %1, %2" : "=v"(r) : "v"(lo), "v"(hi)); return r; }
__device__ __forceinline__ float bf_lo(unsigned w) { return __uint_as_float(w << 16); }
__device__ __forceinline__ float bf_hi(unsigned w) { return __uint_as_float(w & 0xffff0000u); }
__device__ __forceinline__ int lane_id() { int l; asm volatile("v_mbcnt_lo_u32_b32 %0, -1, 0\n\tv_mbcnt_hi_u32_b32 %0, -1, %0" : "=v"(l)); return l; }
template <class T> __device__ __forceinline__ T* as_global(T* p) { return (T*)(GAS T*)(unsigned long long)p; }
__device__ __forceinline__ unsigned char* opq_p(unsigned char* p) { unsigned long long v = (unsigned long long)p; asm volatile("" : "+s"(v)); return (unsigned char*)(GAS unsigned char*)v; }
__device__ __forceinline__ int opq_s(int v) { asm volatile("" : "+s"(v)); return v; }
__device__ __forceinline__ int opq(int v) { asm volatile("" : "+v"(v)); return v; }
__device__ __forceinline__ float wave_sum(float v) {
#pragma unroll
    for (int o = 1; o < 64; o <<= 1) v += __shfl_xor(v, o);
    return v;
}

#define XB_TMO      128
#define XB_XCNT(j)  (256  + 64 * (j))
#define XB_XSUB(j)  (1280 + 64 * (j))
#define XB_XGEN(j)  (2304 + 64 * (j))
#define XB_TOP      3328
#define XB_TOPGEN   3392
#define XCD_BAR_WORDS 3456
#define XB_SPIN_CAP (1u << 18)
__device__ __forceinline__ unsigned xb_ld(unsigned* p)              { return __hip_atomic_load(p, __ATOMIC_RELAXED, __HIP_MEMORY_SCOPE_AGENT); }
__device__ __forceinline__ unsigned xb_add(unsigned* p, unsigned v) { return __hip_atomic_fetch_add(p, v, __ATOMIC_RELAXED, __HIP_MEMORY_SCOPE_AGENT); }
__device__ __forceinline__ unsigned xb_xcc_id() { return (unsigned)__builtin_amdgcn_s_getreg((3 << 11) | 20) & 0xFu; }
#define XB_SPIN(cond, bar) do { unsigned _sp = 0; while (cond) { __builtin_amdgcn_s_sleep(1); \
    if ((++_sp & 255u) == 0u) { if (xb_ld(&(bar)[XB_TMO])) break; if (_sp > XB_SPIN_CAP) { atomicAdd(&(bar)[XB_TMO], 1u); break; } } } } while (0)
struct XcdBarrier { unsigned* bar; unsigned x; volatile LAS unsigned* st; };
__device__ __forceinline__ XcdBarrier xcd_barrier_post(unsigned* bar, volatile LAS unsigned* st) {
    XcdBarrier b; b.bar = bar; b.x = xb_xcc_id(); b.st = st;
    if (threadIdx.x == 0) (void)xb_add(&bar[XB_XCNT(b.x)], 1u);
    return b;
}
__device__ __forceinline__ void xcd_barrier_complete(unsigned* bar, unsigned x, unsigned& nloc, unsigned& nx) {
    const unsigned G = gridDim.x * gridDim.y * gridDim.z;
    unsigned sum, cnt, mine, sp = 0u;
    for (;;) {
        sum = 0u; cnt = 0u; mine = 0u;
#pragma unroll
        for (unsigned j = 0; j < 16; ++j) { const unsigned c = xb_ld(&bar[XB_XCNT(j)]); sum += c; cnt += (c > 0u) ? 1u : 0u; mine = (j == x) ? c : mine; }
        if (sum == G) break;
        __builtin_amdgcn_s_sleep(1);
        if ((++sp & 255u) == 0u) { if (xb_ld(&bar[XB_TMO])) break; if (sp > XB_SPIN_CAP) { atomicAdd(&bar[XB_TMO], 1u); break; } }
    }
    nloc = mine > 0u ? mine : 1u; nx = cnt > 0u ? cnt : 1u;
}
__device__ __forceinline__ void xcd_barrier(const XcdBarrier& b, const bool leader) {
    asm volatile("s_waitcnt vmcnt(0)" ::: "memory");
    __syncthreads();
    if (leader) {
        unsigned* bar = b.bar;
        __builtin_amdgcn_s_waitcnt(0);
        unsigned nloc = b.st[0], nx = b.st[1];
        if (nloc == 0u) { xcd_barrier_complete(bar, b.x, nloc, nx); b.st[0] = nloc; b.st[1] = nx; }
        const unsigned old = xb_add(&bar[XB_XSUB(b.x)], 1u);
        const unsigned gen = old / nloc;
        if (old + 1u == (gen + 1u) * nloc) {
            __builtin_amdgcn_fence(__ATOMIC_RELEASE, "agent");
            asm volatile("s_waitcnt vmcnt(0)" ::: "memory");
            const unsigned og = xb_add(&bar[XB_TOP], 1u);
            const unsigned tg = og / nx;
            if (og + 1u == (tg + 1u) * nx) xb_add(&bar[XB_TOPGEN], 1u);
            else XB_SPIN(xb_ld(&bar[XB_TOPGEN]) == tg, bar);
            __builtin_amdgcn_fence(__ATOMIC_ACQUIRE, "agent");
            xb_add(&bar[XB_XGEN(b.x)], 1u);
            asm volatile("s_waitcnt vmcnt(0)" ::: "memory");
        } else {
            XB_SPIN(xb_ld(&bar[XB_XGEN(b.x)]) == gen, bar);
            __builtin_amdgcn_fence(__ATOMIC_ACQUIRE, "agent");
            asm volatile("s_waitcnt vmcnt(0)" ::: "memory");
        }
    }
    __syncthreads();
}

namespace pg8 {
constexpr float ATT_SC_ = 0.044194173824159216f * 1.4426950408889634f;
constexpr int BM = 256, BK = 64, HALF = 128, HTB = HALF * BK * 2, NXCD = 8, WGM = 8;
__host__ __device__ __forceinline__ int lds_byte(int r, int c) { const int st = (r >> 4) * 2 + (c >> 5), rr = r & 15, cc = c & 31, ob = rr * 64 + cc * 2; return st * 1024 + (ob ^ (((ob >> 9) & 1) << 5)); }
__host__ __device__ __forceinline__ void stage_rc(int b, int& R, int& C) { const int st = b / 1024, sb = b % 1024, swz = sb ^ (((sb >> 9) & 1) << 5); R = (st >> 1) * 16 + swz / 64; C = (st & 1) * 32 + (swz % 64) / 2; }
__host__ __device__ __forceinline__ int perm32(int rho) { const int n = rho >> 4, i = rho & 15; return 8 * (i >> 2) + 4 * n + (i & 3); }

struct Unit { const char* a; const char* b; char* c; int ldc; int cn; int nt; int lda, ldb; char* c2; int row0; };
__device__ __forceinline__ void tile_of(int wgid, int nM, int nN, int& pm, int& pn) {
    const int nwg = nM * nN;
    { const int q = nwg / NXCD, r = nwg % NXCD, xcd = wgid % NXCD, off = wgid / NXCD; wgid = (xcd < r ? xcd * (q + 1) : r * (q + 1) + (xcd - r) * q) + off; }
    const int nig = WGM * nN, gid = wgid / nig, fm = gid * WGM, gsz = (nM - fm) < WGM ? (nM - fm) : WGM;
    pm = fm + ((wgid % nig) % gsz); pn = (wgid % nig) / gsz;
}
struct SchedG {
    const char* A; const char* B; char* C; int lda, ldb, ldc, nM, nN, csz, G, c, grp_shift, grp_kbytes;
    __device__ __forceinline__ bool next(int i, Unit& u) const {
        const int L = i * G + c; if (L >= nM * nN) return false;
        int pm, pn; tile_of(L, nM, nN, pm, pn);
        u.a = A + (size_t)pm * BM * lda * 2 + (size_t)((pn >> grp_shift) * grp_kbytes);
        u.b = B + (size_t)pn * BM * ldb * 2;
        u.c = C + ((size_t)pm * BM * ldc + (size_t)pn * BM) * csz; u.ldc = ldc; u.cn = pn * BM; u.row0 = pm * BM; return true;
    }
};
struct SchedGS {
    const char* A; const char* B; char* C; char* SLAB; int lda, ldb, K, csz, G, c, ssz;
    __device__ __forceinline__ bool next(int i, Unit& u) const {
        const int L = i * G + c; if (L >= 512) return false;
        u.ldc = D;
        if (L < 256) { int pm, pn; tile_of(L, 32, 8, pm, pn);
            u.a = A + (size_t)pm * BM * lda * 2; u.b = B + (size_t)pn * BM * ldb * 2; u.c = C + ((size_t)pm * BM * D + (size_t)pn * BM) * csz; u.cn = 0; u.nt = K / BK; u.row0 = pm * BM; }
        else { const int j = L - 256, ts = j >> 3, ks = j & 7, pm = ts >> 3, pn = ts & 7; const size_t kb = (size_t)ks * (K / 8) * 2;
            u.a = A + (size_t)(TP + pm * BM) * lda * 2 + kb; u.b = B + (size_t)pn * BM * ldb * 2 + kb;
            u.c = SLAB + (((size_t)ks * TS + pm * BM) * D + (size_t)pn * BM) * ssz; u.cn = 1; u.nt = K / (8 * BK); u.row0 = TP + pm * BM; }
        return true;
    }
};
struct SchedWP {
    const char* WOUTB; const char* WPS; char* WPT; int G, c;
    __device__ __forceinline__ bool next(int i, Unit& u) const {
        const int j = (G == 256) ? (((c & 3) == 3) ? (c >> 2) : -1) : c;
        if (i > 0 || j < 0 || j >= 64) return false;
        const int g = j >> 4, rt = (j >> 1) & 7, ct = j & 1;
        u.a = WOUTB + ((size_t)(rt * 256) * D + g * 512) * 2; u.b = WPS + ((size_t)(g * 512 + ct * 256) * 512) * 2;
        u.c = WPT + ((size_t)(rt * 256) * D + g * 512 + ct * 256) * 2; u.ldc = D; u.cn = 0; return true;
    }
};
struct SchedP1 {
    const char* HN; const char* WINA; char* QS; char* FL; char* VI; char* GS; const char* MEMN; const char* WXKV; char* OUTK; char* OUTV; char* KPB; char* VPB; int G, c;
    __device__ __forceinline__ bool next(int i, Unit& u) const {
        const int L = i * G + c; if (L >= 1280) return false;
        if (L < 1152) { int pm, pn; tile_of(L, 36, 32, pm, pn); const int reg = pn >> 3, pc = pn & 7;
            u.a = HN + (size_t)pm * BM * D * 2; u.b = WINA + (size_t)pn * BM * D * 2; u.ldc = D; u.row0 = pm * BM;
            const size_t eo = (size_t)pm * BM * D + (size_t)pc * BM;
            if (reg == 0) { u.c = QS + eo * 2; u.cn = 2; } else if (reg == 1) { u.c = FL + eo * 2; u.cn = 1; } else if (reg == 2) { u.c = VI + eo * 2; u.cn = 1; } else { u.c = GS + eo * 2; u.cn = 2; } }
        else { const int j = L - 1152, l = j >> 6, jj = j & 63, pm = jj & 3, pn = jj >> 2;
            u.a = MEMN + ((size_t)l * 1024 + pm * BM) * D * 2; u.b = WXKV + ((size_t)l * 4096 + pn * BM) * D * 2;
            const size_t eo2 = ((size_t)l * 1024 + pm * BM) * D + (size_t)(pn & 7) * BM;
            u.c = (pn < 8 ? OUTK : OUTV) + eo2 * 4; u.c2 = (pn < 8 ? KPB : VPB) + eo2 * 2; u.ldc = D; u.cn = 0; }
        return true;
    }
};
struct EpiF32 {
    static constexpr bool PERM = false; float oscale;
    __device__ __forceinline__ void operator()(const f32x4 (&acc)[2][2][4][2], const Unit& u, int wr, int wc, int fr_, int fq_) const {
        const int fr = opq(fr_), fq = opq(fq_);
        const int row0 = wr * 64 + fr, col0 = wc * 32 + 4 * fq; float* C = as_global((float*)u.c);
#pragma unroll
        for (int ai = 0; ai < 2; ++ai)
#pragma unroll
            for (int m = 0; m < 4; ++m) { float* rowp = C + (size_t)(row0 + ai * HALF + m * 16) * u.ldc + col0;
#pragma unroll
                for (int bj = 0; bj < 2; ++bj)
#pragma unroll
                    for (int n = 0; n < 2; ++n) *(f32x4*)(rowp + bj * HALF + n * 16) = acc[ai][bj][m][n] * oscale; }
    }
};
struct EpiP1 {
    static constexpr bool PERM = true; const float* rs;
    __device__ __forceinline__ void operator()(const f32x4 (&acc)[2][2][4][2], const Unit& u, int wr, int wc, int fr_, int fq_) const {
        const int fr = opq(fr_), fq = opq(fq_);
        const int row0 = wr * 64 + fr, col0 = wc * 32 + 8 * fq;
        if (u.cn == 0) { float* C = as_global((float*)u.c); bf16* C2 = as_global((bf16*)u.c2);
#pragma unroll
            for (int ai = 0; ai < 2; ++ai)
#pragma unroll
                for (int m = 0; m < 4; ++m) { const size_t ro = (size_t)(row0 + ai * HALF + m * 16) * u.ldc + col0;
#pragma unroll
                    for (int bj = 0; bj < 2; ++bj) { const f32x4 v0 = acc[ai][bj][m][0], v1 = acc[ai][bj][m][1];
                        __builtin_nontemporal_store(v0, (f32x4*)(C + ro + bj * HALF)); __builtin_nontemporal_store(v1, (f32x4*)(C + ro + bj * HALF + 4));
                        v4u w; w.x = cvt_pk_bf16(v0[0], v0[1]); w.y = cvt_pk_bf16(v0[2], v0[3]); w.z = cvt_pk_bf16(v1[0], v1[1]); w.w = cvt_pk_bf16(v1[2], v1[3]);
                        *(v4u*)(C2 + ro + bj * HALF) = w; } }
        } else if (u.cn == 1) { bf16* O = as_global((bf16*)u.c);
#pragma unroll
            for (int ai = 0; ai < 2; ++ai)
#pragma unroll
                for (int m = 0; m < 4; ++m) { bf16* rowp = O + (size_t)(row0 + ai * HALF + m * 16) * u.ldc + col0; const float rsv = rs[u.row0 + row0 + ai * HALF + m * 16];
#pragma unroll
                    for (int bj = 0; bj < 2; ++bj) { const f32x4 v0 = acc[ai][bj][m][0] * rsv, v1 = acc[ai][bj][m][1] * rsv;
                        v4u w; w.x = cvt_pk_bf16(v0[0], v0[1]); w.y = cvt_pk_bf16(v0[2], v0[3]); w.z = cvt_pk_bf16(v1[0], v1[1]); w.w = cvt_pk_bf16(v1[2], v1[3]);
                        *(v4u*)(rowp + bj * HALF) = w; } }
        } else { bf16* O = as_global((bf16*)u.c);
#pragma unroll
            for (int ai = 0; ai < 2; ++ai)
#pragma unroll
                for (int m = 0; m < 4; ++m) { bf16* rowp = O + (size_t)(row0 + ai * HALF + m * 16) * u.ldc + col0; const float rsv = rs[u.row0 + row0 + ai * HALF + m * 16];
#pragma unroll
                    for (int bj = 0; bj < 2; ++bj) { f32x4 v0 = acc[ai][bj][m][0] * rsv, v1 = acc[ai][bj][m][1] * rsv;
#pragma unroll
                        for (int j = 0; j < 4; ++j) { v0[j] = v0[j] * __builtin_amdgcn_rcpf(1.0f + __expf(-v0[j])); v1[j] = v1[j] * __builtin_amdgcn_rcpf(1.0f + __expf(-v1[j])); }
                        v4u w; w.x = cvt_pk_bf16(v0[0], v0[1]); w.y = cvt_pk_bf16(v0[2], v0[3]); w.z = cvt_pk_bf16(v1[0], v1[1]); w.w = cvt_pk_bf16(v1[2], v1[3]);
                        *(v4u*)(rowp + bj * HALF) = w; } }
        }
    }
};
template <int ACT  > struct EpiBf16 {
    static constexpr bool PERM = true;
    const float* scale;
    __device__ __forceinline__ void operator()(const f32x4 (&acc)[2][2][4][2], const Unit& u, int wr, int wc, int fr_, int fq_) const {
        const int fr = opq(fr_), fq = opq(fq_);
        const int row0 = wr * 64 + fr, col0 = wc * 32 + 8 * fq; bf16* O = as_global((bf16*)u.c);
        f32x4 sv[2][2];
#pragma unroll
        for (int bj = 0; bj < 2; ++bj)
#pragma unroll
            for (int n = 0; n < 2; ++n) sv[bj][n] = (ACT == 2) ? *(const f32x4*)(scale + u.cn + col0 + bj * HALF + 4 * n) : (f32x4){1.f, 1.f, 1.f, 1.f};
#pragma unroll
        for (int ai = 0; ai < 2; ++ai)
#pragma unroll
            for (int m = 0; m < 4; ++m) { bf16* rowp = O + (size_t)(row0 + ai * HALF + m * 16) * u.ldc + col0;
                const float rsv = (ACT != 2 && scale) ? scale[u.row0 + row0 + ai * HALF + m * 16] : 1.0f;
#pragma unroll
                for (int bj = 0; bj < 2; ++bj) { f32x4 v0 = acc[ai][bj][m][0] * rsv, v1 = acc[ai][bj][m][1] * rsv;
                    if (ACT == 1) {
#pragma unroll
                        for (int j = 0; j < 4; ++j) { const float a = fmaxf(v0[j], 0.f), b = fmaxf(v1[j], 0.f); v0[j] = a * a; v1[j] = b * b; } }
                    if (ACT == 2) { v0 = v0 * sv[bj][0]; v1 = v1 * sv[bj][1]; }
                    v4u w; w.x = cvt_pk_bf16(v0[0], v0[1]); w.y = cvt_pk_bf16(v0[2], v0[3]); w.z = cvt_pk_bf16(v1[0], v1[1]); w.w = cvt_pk_bf16(v1[2], v1[3]);
                    *(v4u*)(rowp + bj * HALF) = w; } }
    }
};

struct SchedWK {
    const char* KPB; const char* WXQN; char* WKT; int G, c, first;
    __device__ __forceinline__ bool next(int i, Unit& u) const {
        const int j = c - first; if (i > 0 || j < 0 || j >= 128) return false;
        const int b = j >> 5, h = (j >> 3) & 3, kt = j & 7;
        u.a = KPB + ((size_t)(b * 256) * D + h * 512) * 2; u.b = WXQN + ((size_t)(kt * 256) * D + h * 512) * 2;
        u.c = WKT + ((size_t)(b * 1024 + h * 256) * D + (size_t)kt * 256) * 2; u.ldc = D; u.cn = 0; u.row0 = 0; return true;
    }
};
struct SchedS {
    const char* XB; const char* WKT; char* P; int G, c;
    __device__ __forceinline__ bool next(int i, Unit& u) const {
        const int L = c; if (i > 0 || L >= 128) return false;
        const int b = L >> 5, h = (L >> 3) & 3, rt = L & 7;
        u.a = XB + ((size_t)(b * SEQ + rt * 256) * D) * 2; u.b = WKT + ((size_t)(b * 1024 + h * 256) * D) * 2;
        u.c = P + ((size_t)(b * SEQ + rt * 256) * 1024 + h * 256) * 2; u.ldc = 1024; u.cn = 0; u.row0 = b * SEQ + rt * 256; return true;
    }
};
struct SchedXQS {
    const char* XB; const char* WXQ; char* SLAB; int G, c;
    __device__ __forceinline__ bool next(int i, Unit& u) const {
        const int j = (c - 128) * 2 + i; if (i > 1 || c < 128 || c >= 256) return false;
        const int ts = j >> 3, ks = j & 7, pm = ts >> 3, pn = ts & 7; const size_t kb = (size_t)ks * (D / 8) * 2;
        u.a = XB + (size_t)(TP + pm * BM) * D * 2 + kb; u.b = WXQ + (size_t)pn * BM * D * 2 + kb;
        u.c = SLAB + (((size_t)ks * TS + pm * BM) * D + (size_t)pn * BM) * 2; u.ldc = D; u.cn = 1; u.nt = 4; u.row0 = TP + pm * BM; return true;
    }
};
struct SchedAtt1V {
    const char* Q; const char* KPB; char* P; const char* WXO; const char* VPB; char* VWT; int G, c, which;
    __device__ __forceinline__ bool next(int i, Unit& u) const {
        const int L = i * G + c; if (L >= 256 || (L < 128) != (which == 0)) return false;
        if (L < 128) { const int b = L >> 5, h = (L >> 3) & 3, rt = L & 7;
            u.a = Q + ((size_t)(b * SEQ + rt * 256) * D + h * 512) * 2; u.b = KPB + ((size_t)(b * 256) * D + h * 512) * 2;
            u.c = P + ((size_t)(b * SEQ + rt * 256) * 1024 + h * 256) * 2; u.ldc = 1024; u.cn = 0; }
        else { const int j = L - 128, b = j >> 5, h = (j >> 3) & 3, n8 = j & 7;
            u.a = WXO + ((size_t)(n8 * 256) * D + h * 512) * 2; u.b = VPB + ((size_t)(b * 256) * D + h * 512) * 2;
            u.c = VWT + ((size_t)(b * D + n8 * 256) * 1024 + h * 256) * 2; u.ldc = 1024; u.cn = 0; }
        return true;
    }
};
struct SchedXO {
    const char* P; const char* VWT; char* M; const char* AO; const char* WXO; char* SLAB; int G, c;
    __device__ __forceinline__ bool next(int i, Unit& u) const {
        const int L = i * G + c; if (L >= 512) return false;
        u.ldc = D;
        if (L < 256) { const int x = L & 7, q = L >> 3, panel = x * 4 + (q >> 3), pn = q & 7, b = panel >> 3, rt = panel & 7;
            u.a = P + ((size_t)(b * SEQ + rt * 256) * 1024) * 2; u.b = VWT + ((size_t)(b * D + pn * 256) * 1024) * 2;
            u.c = M + ((size_t)(b * SEQ + rt * 256) * D + (size_t)pn * 256) * 2; u.cn = 0; u.nt = 16; u.lda = 1024; u.ldb = 1024; }
        else { const int j = L - 256, ts = j >> 3, ks = j & 7, pm = ts >> 3, pn = ts & 7; const size_t kb = (size_t)ks * (D / 8) * 2;
            u.a = AO + (size_t)(TP + pm * BM) * D * 2 + kb; u.b = WXO + (size_t)pn * BM * D * 2 + kb;
            u.c = SLAB + (((size_t)ks * TS + pm * BM) * D + (size_t)pn * BM) * 2; u.cn = 1; u.nt = 4; u.lda = D; u.ldb = D; }
        return true;
    }
};
struct SchedAtt1 {
    const char* Q; const char* KPB; char* P; int G, c;
    __device__ __forceinline__ bool next(int i, Unit& u) const {
        const int L = i * G + c; if (L >= 128) return false;
        const int b = L >> 5, h = (L >> 3) & 3, rt = L & 7;
        u.a = Q + ((size_t)(b * SEQ + rt * 256) * D + h * 512) * 2; u.b = KPB + ((size_t)(b * 256) * D + h * 512) * 2;
        u.c = P + ((size_t)(b * SEQ + rt * 256) * 1024 + h * 256) * 2; u.ldc = 1024; u.cn = 0; return true;
    }
};
struct SchedAtt2 {
    const char* P; const char* VPT; char* AO; int G, c;
    __device__ __forceinline__ bool next(int i, Unit& u) const {
        const int L = i * G + c; if (L >= 256) return false;
        const int b = L >> 6, h = (L >> 4) & 3, rt = (L >> 1) & 7, nh = L & 1;
        u.a = P + ((size_t)(b * SEQ + rt * 256) * 1024 + h * 256) * 2; u.b = VPT + ((size_t)((b * 4 + h) * 512 + nh * 256) * 256) * 2;
        u.c = AO + ((size_t)(b * SEQ + rt * 256) * D + h * 512 + nh * 256) * 2; u.ldc = D; u.cn = 0; return true;
    }
};
struct EpiSoftmax {
    static constexpr bool PERM = true;
    LAS unsigned char* xl; const float* rs;
    __device__ __forceinline__ void operator()(f32x4 (&acc)[2][2][4][2], const Unit& u, int wr, int wc, int fr_, int fq_) const {
        const int fr = opq(fr_), fq = opq(fq_);
        LAS float* smax = (LAS float*)xl; LAS float* ssum = smax + 1024;
        const int row0 = wr * 64 + fr, col0 = wc * 32 + 8 * fq; bf16* O = as_global((bf16*)u.c);
#pragma unroll
        for (int ai = 0; ai < 2; ++ai)
#pragma unroll
            for (int m = 0; m < 4; ++m) { float mx = -3.0e38f; const float rsc = rs ? ATT_SC_ * rs[u.row0 + row0 + ai * HALF + m * 16] : ATT_SC_;
#pragma unroll
                for (int bj = 0; bj < 2; ++bj)
#pragma unroll
                    for (int n = 0; n < 2; ++n) { acc[ai][bj][m][n] = acc[ai][bj][m][n] * rsc; const f32x4 x = acc[ai][bj][m][n]; mx = fmaxf(mx, fmaxf(fmaxf(x[0], x[1]), fmaxf(x[2], x[3]))); }
                mx = fmaxf(mx, __shfl_xor(mx, 16)); mx = fmaxf(mx, __shfl_xor(mx, 32));
                if (fq == 0) smax[(row0 + ai * HALF + m * 16) * 4 + wc] = mx; }
        asm volatile("s_waitcnt lgkmcnt(0)" ::: "memory"); __builtin_amdgcn_s_barrier(); asm volatile("" ::: "memory");
#pragma unroll
        for (int ai = 0; ai < 2; ++ai)
#pragma unroll
            for (int m = 0; m < 4; ++m) { const f32x4 mv = *(const LAS f32x4*)(smax + (row0 + ai * HALF + m * 16) * 4); const float M = fmaxf(fmaxf(mv[0], mv[1]), fmaxf(mv[2], mv[3])); float sm = 0.f;
#pragma unroll
                for (int bj = 0; bj < 2; ++bj)
#pragma unroll
                    for (int n = 0; n < 2; ++n) {
#pragma unroll
                        for (int e = 0; e < 4; ++e) { const float pv = __builtin_amdgcn_exp2f(acc[ai][bj][m][n][e] - M); acc[ai][bj][m][n][e] = pv; sm += pv; } }
                sm += __shfl_xor(sm, 16); sm += __shfl_xor(sm, 32);
                if (fq == 0) ssum[(row0 + ai * HALF + m * 16) * 4 + wc] = sm; }
        asm volatile("s_waitcnt lgkmcnt(0)" ::: "memory"); __builtin_amdgcn_s_barrier(); asm volatile("" ::: "memory");
#pragma unroll
        for (int ai = 0; ai < 2; ++ai)
#pragma unroll
            for (int m = 0; m < 4; ++m) { const f32x4 sv = *(const LAS f32x4*)(ssum + (row0 + ai * HALF + m * 16) * 4); const float inv = 1.0f / ((sv[0] + sv[1]) + (sv[2] + sv[3]));
                bf16* rowp = O + (size_t)(opq(row0) + ai * HALF + m * 16) * u.ldc + opq(col0);
#pragma unroll
                for (int bj = 0; bj < 2; ++bj) { const f32x4 v0 = acc[ai][bj][m][0] * inv, v1 = acc[ai][bj][m][1] * inv;
                    v4u w; w.x = cvt_pk_bf16(v0[0], v0[1]); w.y = cvt_pk_bf16(v0[2], v0[3]); w.z = cvt_pk_bf16(v1[0], v1[1]); w.w = cvt_pk_bf16(v1[2], v1[3]);
                    *(v4u*)(rowp + bj * HALF) = w; } }
    }
};

template <class Epi, class Sched, bool SMALLK = false, bool SPLIT = false, bool MIX = false>
__device__ __forceinline__ void gemm_phase(LAS unsigned char* lds, const int wid_, const int lda, const int ldb, const int K, const Sched& S, const Epi& E) {
    const int wid = opq_s(wid_); const int lane = lane_id(), tid = wid * 64 + lane, wr = wid >> 2, wc = wid & 3, fr = lane & 15, fq = lane >> 4;
    const int nt0 = SMALLK ? opq_s(K / BK) : K / BK;
    unsigned voffA[2], voffB[2], nvoffA[2], nvoffB[2]; int sR[2], sC[2], sRb[2];
#pragma unroll
    for (int i = 0; i < 2; ++i) { int R, C; stage_rc(tid * 16 + i * 8192, R, C); const int Rb = Epi::PERM ? ((R & ~31) + perm32(R & 31)) : R; sR[i] = R; sC[i] = C; sRb[i] = Rb;
        voffA[i] = (unsigned)(R * lda + C) * 2u; voffB[i] = (unsigned)(Rb * ldb + C) * 2u; nvoffA[i] = voffA[i]; nvoffB[i] = voffB[i]; }
    const size_t kstep = (size_t)(BK * 2);
    size_t hstepA = (size_t)HALF * lda * 2, hstepB = (size_t)HALF * ldb * 2, nhstepA = hstepA, nhstepB = hstepB;
    const unsigned ldsw = (unsigned)wid * 1024u;
    const int aoff = lds_byte(wr * 64 + fr, fq * 8), boff = lds_byte(wc * 32 + fr, fq * 8);
#define PG8_SA(b, h) (((b) * 2 + (h)) * HTB)
#define PG8_SB(b, h) ((4 + (b) * 2 + (h)) * HTB)
#define PG8_STAGE(bufoff, gbase, voff) do { _Pragma("unroll") for (int _i = 0; _i < 2; ++_i) \
        __builtin_amdgcn_global_load_lds((const unsigned*)((const char*)(gbase) + (voff)[_i]), (LAS unsigned*)(lds + (bufoff) + ldsw + _i * 8192), 16, 0, 0); } while (0)
#define PG8_LDA(dst, b, h) do { _Pragma("unroll") for (int m = 0; m < 4; ++m) _Pragma("unroll") for (int k = 0; k < 2; ++k) dst[m][k] = *(const LAS bf16x8*)(lds + PG8_SA(b, h) + aoff + m * 2048 + k * 1024); } while (0)
#define PG8_LDB(dst, b, h) do { _Pragma("unroll") for (int n = 0; n < 2; ++n) _Pragma("unroll") for (int k = 0; k < 2; ++k) dst[n][k] = *(const LAS bf16x8*)(lds + PG8_SB(b, h) + boff + n * 2048 + k * 1024); } while (0)
#define PG8_MMA(ai, bj, At, Bt) do { __builtin_amdgcn_s_setprio(1); _Pragma("unroll") for (int m = 0; m < 4; ++m) _Pragma("unroll") for (int n = 0; n < 2; ++n) _Pragma("unroll") for (int k = 0; k < 2; ++k) \
        acc[ai][bj][m][n] = __builtin_amdgcn_mfma_f32_16x16x32_bf16(Bt[n][k], At[m][k], acc[ai][bj][m][n], 0, 0, 0); __builtin_amdgcn_s_setprio(0); } while (0)
#define PG8_WAIT_V(n) asm volatile("s_waitcnt vmcnt(" #n ")" ::: "memory")
#define PG8_WAIT_L(n) asm volatile("s_waitcnt lgkmcnt(" #n ")" ::: "memory")
#define PG8_BAR __builtin_amdgcn_s_barrier()
#define PG8_SCHED __builtin_amdgcn_sched_barrier(0)
    Unit cur, nxt; int ui = 0;
    if (!S.next(0, cur)) return;
    f32x4 acc[2][2][4][2];
#pragma unroll
    for (int a = 0; a < 2; ++a)
#pragma unroll
        for (int b = 0; b < 2; ++b)
#pragma unroll
            for (int m = 0; m < 4; ++m)
#pragma unroll
                for (int n = 0; n < 2; ++n) acc[a][b][m][n] = (f32x4){0.f, 0.f, 0.f, 0.f};
    bf16x8 At[4][2], B0[2][2], B1[2][2];
    const char* cA = cur.a; const char* cB = cur.b;
    if constexpr (MIX) {
#pragma unroll
        for (int i = 0; i < 2; ++i) { voffA[i] = (unsigned)(sR[i] * cur.lda + sC[i]) * 2u; voffB[i] = (unsigned)(sRb[i] * cur.ldb + sC[i]) * 2u; }
        hstepA = (size_t)HALF * cur.lda * 2; hstepB = (size_t)HALF * cur.ldb * 2; }
    PG8_STAGE(PG8_SB(0, 0), cB, voffB); PG8_STAGE(PG8_SB(0, 1), cB + hstepB, voffB); PG8_STAGE(PG8_SA(0, 0), cA, voffA); PG8_STAGE(PG8_SA(0, 1), cA + hstepA, voffA);
    if (wr == 1) PG8_BAR;
    PG8_WAIT_V(2); PG8_BAR;
    PG8_STAGE(PG8_SB(1, 0), cB + kstep, voffB); PG8_STAGE(PG8_SA(1, 0), cA + kstep, voffA); PG8_STAGE(PG8_SB(1, 1), cB + hstepB + kstep, voffB);
    PG8_WAIT_V(6); PG8_BAR;
    for (;;) {
        const bool has_next = S.next(ui + 1, nxt);
        const char* nA = has_next ? nxt.a : cA; const char* nB = has_next ? nxt.b : cB;
        if constexpr (MIX) { const int la = has_next ? nxt.lda : cur.lda, lb = has_next ? nxt.ldb : cur.ldb;
#pragma unroll
            for (int i = 0; i < 2; ++i) { nvoffA[i] = (unsigned)(sR[i] * la + sC[i]) * 2u; nvoffB[i] = (unsigned)(sRb[i] * lb + sC[i]) * 2u; }
            nhstepA = (size_t)HALF * la * 2; nhstepB = (size_t)HALF * lb * 2; }
#define PG8_KITER \
            const bool last = (t == nt - 2); \
            const char* a1 = cA + (size_t)(t + 1) * kstep; \
            const char* a2 = last ? nA : cA + (size_t)(t + 2) * kstep; const char* b2 = last ? nB : cB + (size_t)(t + 2) * kstep; \
            const char* a3 = a2 + kstep; const char* b3 = b2 + kstep; \
            const bool nx_ = MIX && last; const unsigned vA2[2] = {nx_ ? nvoffA[0] : voffA[0], nx_ ? nvoffA[1] : voffA[1]}, vB2[2] = {nx_ ? nvoffB[0] : voffB[0], nx_ ? nvoffB[1] : voffB[1]}; \
            const size_t hA2 = nx_ ? nhstepA : hstepA, hB2 = nx_ ? nhstepB : hstepB; \
            PG8_LDB(B0, 0, 0); PG8_LDB(B1, 0, 1); PG8_SCHED; PG8_LDA(At, 0, 0); PG8_STAGE(PG8_SA(1, 1), a1 + hstepA, voffA); \
            PG8_WAIT_V(8); PG8_WAIT_L(0); PG8_BAR; PG8_MMA(0, 0, At, B0); PG8_MMA(0, 1, At, B1); PG8_BAR; PG8_SCHED; \
            PG8_LDA(At, 0, 1); PG8_STAGE(PG8_SB(0, 0), b2, vB2); PG8_STAGE(PG8_SB(0, 1), b2 + hB2, vB2); PG8_STAGE(PG8_SA(0, 0), a2, vA2); \
            PG8_WAIT_V(8); PG8_WAIT_L(0); PG8_BAR; PG8_MMA(1, 0, At, B0); PG8_MMA(1, 1, At, B1); PG8_BAR; PG8_SCHED; \
            PG8_LDB(B0, 1, 0); PG8_LDB(B1, 1, 1); PG8_SCHED; PG8_LDA(At, 1, 0); PG8_STAGE(PG8_SA(0, 1), a2 + hA2, vA2); \
            PG8_WAIT_V(8); PG8_WAIT_L(0); PG8_BAR; PG8_MMA(0, 0, At, B0); PG8_MMA(0, 1, At, B1); PG8_BAR; PG8_SCHED; \
            PG8_LDA(At, 1, 1); PG8_STAGE(PG8_SB(1, 0), b3, vB2); PG8_STAGE(PG8_SB(1, 1), b3 + hB2, vB2); PG8_STAGE(PG8_SA(1, 0), a3, vA2); \
            PG8_WAIT_V(8); PG8_WAIT_L(0); PG8_BAR; PG8_MMA(1, 0, At, B0); PG8_MMA(1, 1, At, B1); PG8_BAR; PG8_SCHED;
        const int nt = SPLIT ? cur.nt : nt0;
        if constexpr (SMALLK || SPLIT) {
#pragma unroll 1
            for (int t = 0; t < nt; t += 2) { PG8_KITER }
        } else {
            for (int t = 0; t < nt; t += 2) { PG8_KITER }
        }
        if (wr == 0) PG8_BAR;
        E(acc, cur, wr, wc, fr, fq);
        if (!has_next) break;
#pragma unroll
        for (int a = 0; a < 2; ++a)
#pragma unroll
            for (int b = 0; b < 2; ++b)
#pragma unroll
                for (int m = 0; m < 4; ++m)
#pragma unroll
                    for (int n = 0; n < 2; ++n) acc[a][b][m][n] = (f32x4){0.f, 0.f, 0.f, 0.f};
        cur = nxt; cA = nA; cB = nB; ++ui;
        if constexpr (MIX) { voffA[0] = nvoffA[0]; voffA[1] = nvoffA[1]; voffB[0] = nvoffB[0]; voffB[1] = nvoffB[1]; hstepA = nhstepA; hstepB = nhstepB; }
        if (wr == 1) PG8_BAR;
    }
    PG8_WAIT_V(0);
    PG8_BAR;
#undef PG8_KITER
#undef PG8_SA
#undef PG8_SB
#undef PG8_STAGE
#undef PG8_LDA
#undef PG8_LDB
#undef PG8_MMA
#undef PG8_WAIT_V
#undef PG8_WAIT_L
#undef PG8_BAR
#undef PG8_SCHED
}
}

struct Args { const float* in[27]; float* out; unsigned char* ws; int ph_lo, ph_hi; };
struct Frame {
    LAS unsigned char* lds; unsigned char* ws; float* out;
    int wave, G, gw, ngw;
};

__device__ __forceinline__ void tr_load(f32x4 (&v)[8], const float* W, int ldw, int k0, int n0, int lane, const float* kscale = nullptr) {
    const float* src = W + (size_t)(k0 + 8 * (lane >> 3)) * ldw + n0 + 4 * (lane & 7);
#pragma unroll
    for (int j = 0; j < 8; ++j) v[j] = *(const f32x4*)(src + (size_t)j * ldw);
    if (kscale) {
#pragma unroll
        for (int j = 0; j < 8; ++j) v[j] = v[j] * kscale[k0 + 8 * (lane >> 3) + j]; }
}
__device__ __forceinline__ void tr_store(const f32x4 (&v)[8], bf16* WT, int ldt, int k0, int n0, int lane) {
    bf16* dst = WT + (size_t)(n0 + 4 * (lane & 7)) * ldt + k0 + 8 * (lane >> 3);
#pragma unroll
    for (int e = 0; e < 4; ++e) { v4u o; o.x = cvt_pk_bf16(v[0][e], v[1][e]); o.y = cvt_pk_bf16(v[2][e], v[3][e]); o.z = cvt_pk_bf16(v[4][e], v[5][e]); o.w = cvt_pk_bf16(v[6][e], v[7][e]);
        *(v4u*)(dst + (size_t)e * ldt) = o; }
}
__device__ __forceinline__ int tr_matrix(const Frame& F, const float* W, int K, int N, int ldw, bf16* WT, int ldt, int it0, const float* kscale = nullptr) {
    const int nnb = N / 32, nit = (K / 64) * nnb; const int lane = lane_id();
    int first = (F.gw - it0) % F.ngw; if (first < 0) first += F.ngw;
    for (int it = first; it < nit; it += 2 * F.ngw) { const int it2 = it + F.ngw; const bool two = it2 < nit;
        f32x4 a[8], b[8];
        tr_load(a, W, ldw, (it / nnb) * 64, (it % nnb) * 32, lane, kscale);
        if (two) tr_load(b, W, ldw, (it2 / nnb) * 64, (it2 % nnb) * 32, lane, kscale);
        tr_store(a, WT, ldt, (it / nnb) * 64, (it % nnb) * 32, lane);
        if (two) tr_store(b, WT, ldt, (it2 / nnb) * 64, (it2 % nnb) * 32, lane); }
    return it0 + nit;
}
__device__ __forceinline__ void norm_row(const float* xrow, const float* w, bf16* orow, float* xcopy, int lane) {
    f32x4 v[8]; float ss = 0.f;
#pragma unroll
    for (int j = 0; j < 8; ++j) { v[j] = *(const f32x4*)(xrow + 4 * lane + 256 * j); ss += (v[j][0] * v[j][0] + v[j][1] * v[j][1]) + (v[j][2] * v[j][2] + v[j][3] * v[j][3]); }
    const float r = 1.0f / sqrtf(wave_sum(ss) * (1.0f / D) + EPS);
#pragma unroll
    for (int j = 0; j < 8; ++j) { const f32x4 wv = *(const f32x4*)(w + 4 * lane + 256 * j); const f32x4 y = v[j] * r * wv;
        if (xcopy) *(f32x4*)(xcopy + 4 * lane + 256 * j) = v[j];
        v2u o; o.x = cvt_pk_bf16(y[0], y[1]); o.y = cvt_pk_bf16(y[2], y[3]); *(v2u*)(orow + 4 * lane + 256 * j) = o; }
}
struct TRow { f32x4 v[8], x[8]; };
__device__ __forceinline__ void bf8_to_f32(const v4u w, f32x4& lo, f32x4& hi) { lo = (f32x4){bf_lo(w.x), bf_hi(w.x), bf_lo(w.y), bf_hi(w.y)}; hi = (f32x4){bf_lo(w.z), bf_hi(w.z), bf_lo(w.w), bf_hi(w.w)}; }
__device__ __forceinline__ void t_load(TRow& t, const bf16* Msrc, const float* SLAB, const bf16* XB, const float* Xp, const float* Xs, int row, int lane) {
    if (row >= TP) { const bf16* sr = (const bf16*)SLAB + (size_t)(row - TP) * D + 8 * lane;
#pragma unroll
        for (int j = 0; j < 4; ++j) { bf8_to_f32(__builtin_nontemporal_load((const v4u*)(sr + 512 * j)), t.v[2 * j], t.v[2 * j + 1]);
#pragma unroll
            for (int ks = 1; ks < 8; ++ks) { f32x4 a, b; bf8_to_f32(__builtin_nontemporal_load((const v4u*)(sr + (size_t)ks * TS * D + 512 * j)), a, b); t.v[2 * j] += a; t.v[2 * j + 1] += b; } } }
    else { const bf16* mr = Msrc + (size_t)row * D + 8 * lane;
#pragma unroll
        for (int j = 0; j < 4; ++j) bf8_to_f32(__builtin_nontemporal_load((const v4u*)(mr + 512 * j)), t.v[2 * j], t.v[2 * j + 1]); }
    if (Xp) { const float* xr = (row < TP ? Xp + (size_t)row * D : Xs + (size_t)(row - TP) * D) + 8 * lane;
#pragma unroll
        for (int j = 0; j < 4; ++j) { t.x[2 * j] = *(const f32x4*)(xr + 512 * j); t.x[2 * j + 1] = *(const f32x4*)(xr + 512 * j + 4); } }
    else { const bf16* xr = XB + (size_t)row * D + 8 * lane;
#pragma unroll
        for (int j = 0; j < 4; ++j) bf8_to_f32(*(const v4u*)(xr + 512 * j), t.x[2 * j], t.x[2 * j + 1]); }
}
__device__ __forceinline__ float t_ss(const f32x4 (&v)[8]) { float ss = 0.f;
#pragma unroll
    for (int j = 0; j < 8; ++j) ss += (v[j][0] * v[j][0] + v[j][1] * v[j][1]) + (v[j][2] * v[j][2] + v[j][3] * v[j][3]);
    return ss; }
__device__ __forceinline__ v4u f32_to_bf8(const f32x4 lo, const f32x4 hi) { v4u o; o.x = cvt_pk_bf16(lo[0], lo[1]); o.y = cvt_pk_bf16(lo[2], lo[3]); o.z = cvt_pk_bf16(hi[0], hi[1]); o.w = cvt_pk_bf16(hi[2], hi[3]); return o; }
__device__ __forceinline__ void t_phase(const Frame& F, const bf16* Msrc, const float* SLAB, bf16* XB, float* Yout, const float* wpost, float* RS, const float* Xp = nullptr, const float* Xs = nullptr) {
    const int lane = lane_id();
    const bool deal = F.ngw == 2048; const int gw = F.gw;
    const int nrows = deal ? (gw < 1024 ? 4 : 5) : (gw < MT ? (MT - gw + F.ngw - 1) / F.ngw : 0);
#define T_ROW(k) (deal ? (gw < 1024 ? ((k) == 0 ? TP + gw : 3 * gw + (k) - 1) : 3072 + 5 * (gw - 1024) + (k)) : gw + (k) * F.ngw)
    f32x4 wq[8];
#pragma unroll
    for (int j = 0; j < 4; ++j) { wq[2 * j] = *(const f32x4*)(wpost + 8 * lane + 512 * j); wq[2 * j + 1] = *(const f32x4*)(wpost + 8 * lane + 512 * j + 4); }
    TRow cur, nxt;
    if (nrows > 0) t_load(cur, Msrc, SLAB, XB, Xp, Xs, T_ROW(0), lane);
#pragma unroll 1
    for (int k = 0; k < nrows; ++k) {
        const int row = T_ROW(k);
        if (k + 1 < nrows) t_load(nxt, Msrc, SLAB, XB, Xp, Xs, T_ROW(k + 1), lane);
        const float r = 1.0f / sqrtf(wave_sum(t_ss(cur.v)) * (1.0f / D) + EPS);
#pragma unroll
        for (int j = 0; j < 4; ++j) { cur.v[2 * j] = cur.x[2 * j] + cur.v[2 * j] * r * wq[2 * j]; cur.v[2 * j + 1] = cur.x[2 * j + 1] + cur.v[2 * j + 1] * r * wq[2 * j + 1]; }
        if (Yout) { float* yr = Yout + (size_t)row * D + 8 * lane;
#pragma unroll
            for (int j = 0; j < 4; ++j) { __builtin_nontemporal_store(cur.v[2 * j], (f32x4*)(yr + 512 * j)); __builtin_nontemporal_store(cur.v[2 * j + 1], (f32x4*)(yr + 512 * j + 4)); } }
        else { bf16* xr = XB + (size_t)row * D + 8 * lane;
#pragma unroll
            for (int j = 0; j < 4; ++j) *(v4u*)(xr + 512 * j) = f32_to_bf8(cur.v[2 * j], cur.v[2 * j + 1]); }
        if (RS) { const float r2 = 1.0f / sqrtf(wave_sum(t_ss(cur.v)) * (1.0f / D) + EPS); if (lane == 0) RS[row] = r2; }
        cur = nxt;
    }
#undef T_ROW
}

struct PrepIn { unsigned qv[16], vv[16], fv[16]; };
__device__ __forceinline__ void prep_load(PrepIn& in, const bf16* QS, const bf16* FL, const bf16* VI, const bf16* GS, int c, int h, int lane) {
    const int nt = c < 512 ? 16 : 8;
    const size_t row0 = c < 512 ? (size_t)c * 16 : (size_t)TP + (size_t)(c - 512) * 8;
    const int col = h * 128 + 2 * lane;
#pragma unroll
    for (int t = 0; t < 16; ++t) { const size_t off = (row0 + (t < nt ? t : (t & 7))) * D + col;
        in.qv[t] = __builtin_nontemporal_load((const unsigned*)(QS + off)); in.fv[t] = __builtin_nontemporal_load((const unsigned*)(FL + off)); in.vv[t] = __builtin_nontemporal_load((const unsigned*)(VI + off)); }
}
__device__ __forceinline__ void prep_compute(const PrepIn& in, const float* lbl, unsigned char* REC, int c, int h, int lane) {
    const int nt = c < 512 ? 16 : 8;
    const int k0 = 2 * lane, col = h * 128 + k0;
    const f32x2 l0 = *(const f32x2*)(lbl + col), l1 = *(const f32x2*)(lbl + 2048 + col), l2 = *(const f32x2*)(lbl + 4096 + col);
    unsigned char* rec = REC + ((size_t)c * 16 + h) * REC_BYTES;
    float eb[2][16], ki[2][16], bl[2];
#pragma unroll
    for (int e = 0; e < 2; ++e) {
        const float mx = fmaxf(l0[e], fmaxf(l1[e], l2[e])); const float e0 = __expf(l0[e] - mx), e1 = __expf(l1[e] - mx), e2 = __expf(l2[e] - mx);
        const float inv = 1.0f / (e0 + e1 + e2); const float lb = e0 * inv, oml = (e1 + e2) * inv;
        float b = 0.f;
#pragma unroll
        for (int t = 0; t < 16; ++t) { const float ex = __expf(fminf(-(e == 0 ? bf_lo(in.fv[t]) : bf_hi(in.fv[t])), 80.0f));
            const float sg = __builtin_amdgcn_rcpf(1.0f + ex), sgn = ex * sg;
            const float f = lb + oml * sg, kk = oml * sgn;
            if (t < nt) b += __logf(f);
            const float ebt = __expf(b); eb[e][t] = ebt; ki[e][t] = (t < nt) ? kk * __builtin_amdgcn_rcpf(ebt) : 0.f; }
        bl[e] = __expf(b);
    }
    *(f32x2*)(rec + REC_DEC + k0 * 4) = (f32x2){bl[0], bl[1]};
#pragma unroll
    for (int t = 0; t < 16; ++t) { const bool ok = t < nt;
        const unsigned qd = ok ? cvt_pk_bf16(bf_lo(in.qv[t]) * eb[0][t], bf_hi(in.qv[t]) * eb[1][t]) : 0u;
        *(unsigned*)(rec + REC_KI + t * REC_ROW + k0 * 2) = cvt_pk_bf16(ki[0][t], ki[1][t]); *(unsigned*)(rec + REC_QD + t * REC_ROW + k0 * 2) = qd; }
#pragma unroll
    for (int e = 0; e < 2; ++e) { unsigned kw[8], vw[8];
#pragma unroll
        for (int t = 0; t < 16; t += 2) { kw[t >> 1] = cvt_pk_bf16(ki[e][t] * bl[e], ki[e][t + 1] * bl[e]);
            const unsigned a = (t < nt) ? in.vv[t] : 0u, bq = (t + 1 < nt) ? in.vv[t + 1] : 0u;
            vw[t >> 1] = e == 0 ? ((a & 0xffffu) | (bq << 16)) : ((a >> 16) | (bq & 0xffff0000u)); }
        v4u* kp = (v4u*)(rec + REC_KET + (k0 + e) * 32); v4u* vp = (v4u*)(rec + REC_VT + (k0 + e) * 32);
        kp[0] = (v4u){kw[0], kw[1], kw[2], kw[3]}; kp[1] = (v4u){kw[4], kw[5], kw[6], kw[7]};
        vp[0] = (v4u){vw[0], vw[1], vw[2], vw[3]}; vp[1] = (v4u){vw[4], vw[5], vw[6], vw[7]}; }
}

constexpr int GLA_PARTS_OFF = 4 * SLOT_BYTES;
__device__ __forceinline__ void gla_dma(LAS unsigned char* slot, const unsigned char* rec, int npieces, int w, int lane) {
    for (int pc = w; pc < npieces; pc += 8)
        __builtin_amdgcn_global_load_lds((const unsigned*)(rec + pc * 1024 + lane * 16), (LAS unsigned*)(slot + pc * 1024), 16, 0, 0);
}
__device__ __forceinline__ void gla_dma_full(LAS unsigned char* slot, const unsigned char* rec, const bf16* GS, size_t grow0, int h, int ngs, int w, int lane) {
    for (int pc = w; pc < 18 + ngs; pc += 8) {
        if (pc < 18) __builtin_amdgcn_global_load_lds((const unsigned*)(rec + pc * 1024 + lane * 16), (LAS unsigned*)(slot + pc * 1024), 16, 0, 2);
        else __builtin_amdgcn_global_load_lds((const unsigned*)((const unsigned char*)(GS + (grow0 + 4 * (pc - 18) + (lane >> 4)) * D + h * 128) + 16 * (lane & 15)), (LAS unsigned*)(slot + pc * 1024), 16, 0, 2); }
}
__device__ __forceinline__ void gla_state_step(LAS unsigned char* sb, f32x4 (&S)[8], int w, int r, int g) {
    const bf16x8 z8 = (bf16x8){0, 0, 0, 0, 0, 0, 0, 0};
    bf16x8 vb = *(const LAS bf16x8*)(sb + REC_VT + (16 * w + r) * 32 + 16 * (g & 1)); vb = (g < 2) ? vb : z8;
#pragma unroll
    for (int i = 0; i < 8; ++i) {
        bf16x8 ke = *(const LAS bf16x8*)(sb + REC_KET + (16 * i + r) * 32 + 16 * (g & 1)); ke = (g < 2) ? ke : z8;
        const f32x4 dec = *(const LAS f32x4*)(sb + REC_DEC + (16 * i + 4 * g) * 4);
        S[i] = __builtin_amdgcn_mfma_f32_16x16x32_bf16(ke, vb, S[i] * dec, 0, 0, 0);
    }
}
__device__ __forceinline__ f32x4 gla_out_step(LAS unsigned char* sb, const f32x4 (&S)[8], int w, int r, int g) {
    f32x4 AT = (f32x4){0.f, 0.f, 0.f, 0.f};
#pragma unroll
    for (int p = 0; p < 4; ++p) {
        const bf16x8 ka = *(const LAS bf16x8*)(sb + REC_KI + r * REC_ROW + 64 * p + 16 * g), qb = *(const LAS bf16x8*)(sb + REC_QD + r * REC_ROW + 64 * p + 16 * g);
        AT = __builtin_amdgcn_mfma_f32_16x16x32_bf16(ka, qb, AT, 0, 0, 0);
    }
#pragma unroll
    for (int j = 0; j < 4; ++j) AT[j] = (4 * g + j <= r) ? AT[j] : 0.f;
    v4u pw; pw.x = cvt_pk_bf16(AT[0], AT[1]); pw.y = cvt_pk_bf16(AT[2], AT[3]); pw.z = 0u; pw.w = 0u;
    const v2u vlo = *(const LAS v2u*)(sb + REC_VT + (16 * w + r) * 32 + 8 * g);
    v4u vaw; vaw.x = vlo.x; vaw.y = vlo.y; vaw.z = 0u; vaw.w = 0u;
    f32x4 oT = __builtin_amdgcn_mfma_f32_16x16x32_bf16(__builtin_bit_cast(bf16x8, vaw), __builtin_bit_cast(bf16x8, pw), (f32x4){0.f, 0.f, 0.f, 0.f}, 0, 0, 0);
#pragma unroll
    for (int p = 0; p < 4; ++p) {
        v4u sw; sw.x = cvt_pk_bf16(S[2 * p][0], S[2 * p][1]); sw.y = cvt_pk_bf16(S[2 * p][2], S[2 * p][3]); sw.z = cvt_pk_bf16(S[2 * p + 1][0], S[2 * p + 1][1]); sw.w = cvt_pk_bf16(S[2 * p + 1][2], S[2 * p + 1][3]);
        const v2u q0 = *(const LAS v2u*)(sb + REC_QD + r * REC_ROW + 64 * p + 8 * g), q1 = *(const LAS v2u*)(sb + REC_QD + r * REC_ROW + 64 * p + 32 + 8 * g);
        v4u qw; qw.x = q0.x; qw.y = q0.y; qw.z = q1.x; qw.w = q1.y;
        oT = __builtin_amdgcn_mfma_f32_16x16x32_bf16(__builtin_bit_cast(bf16x8, sw), __builtin_bit_cast(bf16x8, qw), oT, 0, 0, 0);
    }
    return oT;
}
__device__ __forceinline__ void gla_gn_store(LAS unsigned char* lds, LAS unsigned char* sb, const f32x4 oT, const f32x4 hgn, bf16* OG, size_t row, bool valid, int h, int w, int r, int g) {
    LAS float* parts = (LAS float*)(lds + GLA_PARTS_OFF);
    float ss = (oT[0] * oT[0] + oT[1] * oT[1]) + (oT[2] * oT[2] + oT[3] * oT[3]);
    ss += __shfl_xor(ss, 16); ss += __shfl_xor(ss, 32);
    if (g == 0) parts[w * 16 + r] = ss;
    asm volatile("s_waitcnt lgkmcnt(0)" ::: "memory"); __builtin_amdgcn_s_barrier(); asm volatile("" ::: "memory");
    float tot = parts[r];
#pragma unroll
    for (int ww = 1; ww < 8; ++ww) tot += parts[ww * 16 + r];
    const float rstd = 1.0f / sqrtf(tot * (1.0f / 128.0f) + EPS);
    const v2u gw = *(const LAS v2u*)(sb + SLOT_GS + r * 256 + (16 * w + 4 * g) * 2);
    const float y0 = oT[0] * rstd * hgn[0] * bf_lo(gw.x), y1 = oT[1] * rstd * hgn[1] * bf_hi(gw.x), y2 = oT[2] * rstd * hgn[2] * bf_lo(gw.y), y3 = oT[3] * rstd * hgn[3] * bf_hi(gw.y);
    v2u o; o.x = cvt_pk_bf16(y0, y1); o.y = cvt_pk_bf16(y2, y3);
    if (valid) *(v2u*)(OG + row * D + h * 128 + 16 * w + 4 * g) = o;
}
#define GLA_WAIT_BAR(n) do { asm volatile("s_waitcnt vmcnt(" #n ")" ::: "memory"); __builtin_amdgcn_s_barrier(); asm volatile("" ::: "memory"); } while (0)
__device__ __forceinline__ void gla_pass_a(LAS unsigned char* lds, const unsigned char* REC, float* SEND, float* DSEG, int b, int h, int seg, int w, int lane) {
    const int r = lane & 15, g = lane >> 4;
    const unsigned char* rec0 = REC + ((size_t)(b * 128 + seg * 32) * 16 + h) * REC_BYTES;
    f32x4 S[8];
#pragma unroll
    for (int i = 0; i < 8; ++i) S[i] = (f32x4){0.f, 0.f, 0.f, 0.f};
    f32x4 Dc = (f32x4){1.f, 1.f, 1.f, 1.f};
#pragma unroll 1
    for (int j = 0; j < 3; ++j) gla_dma(lds + j * SLOT_BYTES, rec0 + (size_t)j * 16 * REC_BYTES, 9, w, lane);
#pragma unroll 1
    for (int ci = 0; ci < 32; ++ci) {
        if (ci < 3) GLA_WAIT_BAR(0); else if (w == 0) GLA_WAIT_BAR(4); else GLA_WAIT_BAR(2);
        const int cn = ci + 3 < 32 ? ci + 3 : 31;
        gla_dma(lds + ((ci + 3) & 3) * SLOT_BYTES, rec0 + (size_t)cn * 16 * REC_BYTES, 9, w, lane);
        LAS unsigned char* sb = lds + (ci & 3) * SLOT_BYTES;
        gla_state_step(sb, S, w, r, g);
        Dc = Dc * *(const LAS f32x4*)(sb + REC_DEC + (16 * w + 4 * g) * 4);
    }
    float* so = SEND + ((size_t)((b * 16 + h) * 3 + seg)) * 16384;
#pragma unroll
    for (int i = 0; i < 8; ++i)
#pragma unroll
        for (int j = 0; j < 4; ++j) so[(size_t)(16 * i + 4 * g + j) * 128 + 16 * w + r] = S[i][j];
    if (r == 0) *(f32x4*)(DSEG + ((size_t)((b * 16 + h) * 4 + seg)) * 128 + 16 * w + 4 * g) = Dc;
    GLA_WAIT_BAR(0);
}
__device__ __forceinline__ void gla_pass_b(LAS unsigned char* lds, const unsigned char* REC, const bf16* GS, const float* SEND, const float* DSEG, const float* hgnorm, bf16* OG, float* Sfinal, int b, int h, int seg, int w, int lane) {
    const int r = lane & 15, g = lane >> 4;
    const unsigned char* rec0 = REC + ((size_t)(b * 128 + seg * 32) * 16 + h) * REC_BYTES;
    const size_t row0 = (size_t)b * SEQ + seg * 512;
#pragma unroll 1
    for (int j = 0; j < 3; ++j) gla_dma_full(lds + j * SLOT_BYTES, rec0 + (size_t)j * 16 * REC_BYTES, GS, row0 + 16 * j, h, 4, w, lane);
    f32x4 S[8];
#pragma unroll
    for (int i = 0; i < 8; ++i) S[i] = (f32x4){0.f, 0.f, 0.f, 0.f};
#pragma unroll 1
    for (int sp = 0; sp < seg; ++sp) {
        const float* e = SEND + ((size_t)((b * 16 + h) * 3 + sp)) * 16384; const float* dsg = DSEG + ((size_t)((b * 16 + h) * 4 + sp)) * 128;
#pragma unroll
        for (int i = 0; i < 8; ++i) { const f32x4 dv = *(const f32x4*)(dsg + 16 * i + 4 * g);
#pragma unroll
            for (int j = 0; j < 4; ++j) S[i][j] = S[i][j] * dv[j] + e[(size_t)(16 * i + 4 * g + j) * 128 + 16 * w + r]; }
    }
    const f32x4 hgn = *(const f32x4*)(hgnorm + 16 * w + 4 * g);
#pragma unroll 1
    for (int ci = 0; ci < 32; ++ci) {
        if (ci < 3) GLA_WAIT_BAR(0); else if (w < 6) GLA_WAIT_BAR(9); else GLA_WAIT_BAR(7);
        const int cn = ci + 3 < 32 ? ci + 3 : 31;
        gla_dma_full(lds + ((ci + 3) & 3) * SLOT_BYTES, rec0 + (size_t)cn * 16 * REC_BYTES, GS, row0 + 16 * cn, h, 4, w, lane);
        LAS unsigned char* sb = lds + (ci & 3) * SLOT_BYTES;
        const f32x4 oT = gla_out_step(sb, S, w, r, g);
        gla_state_step(sb, S, w, r, g);
        gla_gn_store(lds, sb, oT, hgn, OG, row0 + ci * 16 + r, true, h, w, r, g);
    }
    if (seg == 3) {
#pragma unroll
        for (int i = 0; i < 8; ++i)
#pragma unroll
            for (int j = 0; j < 4; ++j) Sfinal[(size_t)(16 * i + 4 * g + j) * 128 + 16 * w + r] = S[i][j];
    }
    GLA_WAIT_BAR(0);
}
__device__ __forceinline__ void gla_sample(LAS unsigned char* lds, const unsigned char* REC, const bf16* GS, const float* S0, float* Sout, const float* hgnorm, bf16* OG, int b, int h, int w, int lane) {
    const int r = lane & 15, g = lane >> 4;
    gla_dma_full(lds, REC + ((size_t)(512 + b) * 16 + h) * REC_BYTES, GS, (size_t)TP + 8 * b, h, 2, w, lane);
    f32x4 S[8];
#pragma unroll
    for (int i = 0; i < 8; ++i)
#pragma unroll
        for (int j = 0; j < 4; ++j) S[i][j] = __builtin_nontemporal_load(S0 + (size_t)(16 * i + 4 * g + j) * 128 + 16 * w + r);
    const f32x4 hgn = *(const f32x4*)(hgnorm + 16 * w + 4 * g);
    GLA_WAIT_BAR(0);
    const f32x4 oT = gla_out_step(lds, S, w, r, g);
    gla_state_step(lds, S, w, r, g);
    gla_gn_store(lds, lds, oT, hgn, OG, (size_t)TP + 8 * b + (r & 7), r < 8, h, w, r, g);
#pragma unroll
    for (int i = 0; i < 8; ++i)
#pragma unroll
        for (int j = 0; j < 4; ++j) __builtin_nontemporal_store(S[i][j], Sout + (size_t)(16 * i + 4 * g + j) * 128 + 16 * w + r);
    GLA_WAIT_BAR(0);
}

constexpr float ATT_SC = 0.044194173824159216f * 1.4426950408889634f;
__device__ __forceinline__ void attn_sample_block(const Frame& F, const float* QSLAB, const float* Kc, const float* Vc, bf16* AO, int b, int h, LAS unsigned char* xl) {
    const int lane = lane_id(), r = lane & 15, g = lane >> 4, w = F.wave;
    LAS float* smax = (LAS float*)xl;
    LAS float* ssum = smax + 64;
    LAS bf16* Pl = (LAS bf16*)(xl + 512);
    const size_t R0 = (size_t)TP + 8 * b;
    const bf16x8 z8 = (bf16x8){0, 0, 0, 0, 0, 0, 0, 0};
    LAS bf16* Ql = (LAS bf16*)F.lds;
    {   const int tq = w * 64 + lane, qr = tq >> 6, qc = (tq & 63) * 8;
        const bf16* sp = (const bf16*)QSLAB + (size_t)(8 * b + qr) * D + h * 512 + qc;
        f32x4 a0, a1; bf8_to_f32(*(const v4u*)sp, a0, a1);
#pragma unroll
        for (int ks = 1; ks < 8; ++ks) { f32x4 x0, x1; bf8_to_f32(*(const v4u*)(sp + (size_t)ks * TS * D), x0, x1); a0 += x0; a1 += x1; }
        v4u qw; qw.x = cvt_pk_bf16(a0[0], a0[1]); qw.y = cvt_pk_bf16(a0[2], a0[3]); qw.z = cvt_pk_bf16(a1[0], a1[1]); qw.w = cvt_pk_bf16(a1[2], a1[3]);
        *(LAS v4u*)(Ql + qr * 520 + qc) = qw; }
    LDS_WAIT(); __syncthreads();
    bf16x8 qB[16];
#pragma unroll
    for (int p = 0; p < 16; ++p) { const bf16x8 t = *(const LAS bf16x8*)(Ql + (r & 7) * 520 + 32 * p + 8 * g); qB[p] = (r < 8) ? t : z8; }
    f32x4 ST[2];
#pragma unroll
    for (int ii = 0; ii < 2; ++ii) {
        const float* kbase = Kc + ((size_t)b * 256 + 32 * w + 16 * ii + r) * D + h * 512 + 8 * g;
        ST[ii] = (f32x4){0.f, 0.f, 0.f, 0.f};
#pragma unroll
        for (int ph = 0; ph < 2; ++ph) {
            f32x4 kv[16];
#pragma unroll
            for (int p = 0; p < 8; ++p) { kv[2 * p] = __builtin_nontemporal_load((const f32x4*)(kbase + 32 * (8 * ph + p))); kv[2 * p + 1] = __builtin_nontemporal_load((const f32x4*)(kbase + 32 * (8 * ph + p) + 4)); }
#pragma unroll
            for (int p = 0; p < 8; ++p) { const f32x4 k0 = kv[2 * p], k1 = kv[2 * p + 1];
                v4u kw; kw.x = cvt_pk_bf16(k0[0], k0[1]); kw.y = cvt_pk_bf16(k0[2], k0[3]); kw.z = cvt_pk_bf16(k1[0], k1[1]); kw.w = cvt_pk_bf16(k1[2], k1[3]);
                ST[ii] = __builtin_amdgcn_mfma_f32_16x16x32_bf16(__builtin_bit_cast(bf16x8, kw), qB[8 * ph + p], ST[ii], 0, 0, 0); }
        }
    }
    ST[0] = ST[0] * ATT_SC; ST[1] = ST[1] * ATT_SC;
    float mloc = fmaxf(fmaxf(fmaxf(ST[0][0], ST[0][1]), fmaxf(ST[0][2], ST[0][3])), fmaxf(fmaxf(ST[1][0], ST[1][1]), fmaxf(ST[1][2], ST[1][3])));
    mloc = fmaxf(mloc, __shfl_xor(mloc, 16)); mloc = fmaxf(mloc, __shfl_xor(mloc, 32));
    if (g == 0 && r < 8) smax[w * 8 + r] = mloc;
    LDS_WAIT(); __syncthreads();
    float M = smax[r & 7];
#pragma unroll
    for (int ww = 1; ww < 8; ++ww) M = fmaxf(M, smax[ww * 8 + (r & 7)]);
    float lsum = 0.f;
#pragma unroll
    for (int ii = 0; ii < 2; ++ii)
#pragma unroll
        for (int j = 0; j < 4; ++j) { ST[ii][j] = __builtin_amdgcn_exp2f(ST[ii][j] - M); lsum += ST[ii][j]; }
    lsum += __shfl_xor(lsum, 16); lsum += __shfl_xor(lsum, 32);
    if (g == 0 && r < 8) ssum[w * 8 + r] = lsum;
    if (r < 8) {
#pragma unroll
        for (int ii = 0; ii < 2; ++ii) { v2u o; o.x = cvt_pk_bf16(ST[ii][0], ST[ii][1]); o.y = cvt_pk_bf16(ST[ii][2], ST[ii][3]); *(LAS v2u*)(Pl + r * 264 + 32 * w + 16 * ii + 4 * g) = o; }
    }
    LDS_WAIT(); __syncthreads();
    f32x4 O0 = (f32x4){0.f, 0.f, 0.f, 0.f}, O1 = O0, O2 = O0, O3 = O0;
    const float* vbase = Vc + ((size_t)b * 256 + 8 * g) * D + h * 512 + 64 * w + 4 * r;
#pragma unroll 2
    for (int p8 = 0; p8 < 8; ++p8) {
        f32x4 vv[8];
#pragma unroll
        for (int j = 0; j < 8; ++j) vv[j] = __builtin_nontemporal_load((const f32x4*)(vbase + (size_t)(32 * p8 + j) * D));
        const bf16x8 pa = *(const LAS bf16x8*)(Pl + (r & 7) * 264 + 32 * p8 + 8 * g);
        v4u b0, b1, b2, b3;
        b0.x = cvt_pk_bf16(vv[0][0], vv[1][0]); b0.y = cvt_pk_bf16(vv[2][0], vv[3][0]); b0.z = cvt_pk_bf16(vv[4][0], vv[5][0]); b0.w = cvt_pk_bf16(vv[6][0], vv[7][0]);
        b1.x = cvt_pk_bf16(vv[0][1], vv[1][1]); b1.y = cvt_pk_bf16(vv[2][1], vv[3][1]); b1.z = cvt_pk_bf16(vv[4][1], vv[5][1]); b1.w = cvt_pk_bf16(vv[6][1], vv[7][1]);
        b2.x = cvt_pk_bf16(vv[0][2], vv[1][2]); b2.y = cvt_pk_bf16(vv[2][2], vv[3][2]); b2.z = cvt_pk_bf16(vv[4][2], vv[5][2]); b2.w = cvt_pk_bf16(vv[6][2], vv[7][2]);
        b3.x = cvt_pk_bf16(vv[0][3], vv[1][3]); b3.y = cvt_pk_bf16(vv[2][3], vv[3][3]); b3.z = cvt_pk_bf16(vv[4][3], vv[5][3]); b3.w = cvt_pk_bf16(vv[6][3], vv[7][3]);
        O0 = __builtin_amdgcn_mfma_f32_16x16x32_bf16(pa, __builtin_bit_cast(bf16x8, b0), O0, 0, 0, 0);
        O1 = __builtin_amdgcn_mfma_f32_16x16x32_bf16(pa, __builtin_bit_cast(bf16x8, b1), O1, 0, 0, 0);
        O2 = __builtin_amdgcn_mfma_f32_16x16x32_bf16(pa, __builtin_bit_cast(bf16x8, b2), O2, 0, 0, 0);
        O3 = __builtin_amdgcn_mfma_f32_16x16x32_bf16(pa, __builtin_bit_cast(bf16x8, b3), O3, 0, 0, 0);
    }
    if (g < 2) {
#pragma unroll
        for (int j = 0; j < 4; ++j) { const int q = 4 * g + j; float tot = ssum[q];
#pragma unroll
            for (int ww = 1; ww < 8; ++ww) tot += ssum[ww * 8 + q];
            const float inv = 1.0f / tot;
            v2u o; o.x = cvt_pk_bf16(O0[j] * inv, O1[j] * inv); o.y = cvt_pk_bf16(O2[j] * inv, O3[j] * inv);
            *(v2u*)(AO + (R0 + q) * D + h * 512 + 64 * w + 4 * r) = o; }
    }
    LDS_WAIT(); __syncthreads();
}
__device__ __forceinline__ f32x4 ld4bf(const GAS bf16* p) { const v2u w = *(const GAS v2u*)p; return (f32x4){bf_lo(w.x), bf_hi(w.x), bf_lo(w.y), bf_hi(w.y)}; }
template <int W, bool SMP>
__device__ __forceinline__ void pool_unit(const bf16* U, const bf16* SL, const float* spool, bf16* POOLED, int run, int j, int lane_) {
    constexpr int NOUT = 8, NR = NOUT + W - 1;
    const int col = 4 * opq(lane_) + 256 * j;
    f32x4 rows[NR];
    if constexpr (SMP) { const int b = run;
        const GAS float* cp = (const GAS float*)(unsigned long long)(spool + (size_t)(b * 15 + 15 - (W - 1)) * D + col);
#pragma unroll
        for (int i = 0; i < W - 1; ++i) { rows[i] = *(const GAS f32x4*)cp; cp += D; asm volatile("" : "+v"(cp)); }
#pragma unroll
        for (int i = W - 1; i < NR; ++i) rows[i] = (f32x4){0.f, 0.f, 0.f, 0.f};
        const GAS bf16* sp = (const GAS bf16*)(unsigned long long)(SL + (size_t)(8 * b) * D + col);
#pragma unroll 1
        for (int ks = 0; ks < 8; ++ks) { const GAS bf16* q = sp;
#pragma unroll
            for (int i = W - 1; i < NR; ++i) { rows[i] += ld4bf(q); q += D; asm volatile("" : "+v"(q)); }
            sp += (size_t)TS * D; }
    } else { const int t0 = (run & 255) * 8; const bf16* ub = U + (size_t)(run >> 8) * SEQ * D;
        const GAS bf16* q = (const GAS bf16*)(unsigned long long)(ub + (long)(t0 - (W - 1)) * D + col);
#pragma unroll
        for (int i = 0; i < NR; ++i) { const int tt = t0 - (W - 1) + i; rows[i] = (f32x4){0.f, 0.f, 0.f, 0.f}; if (tt >= 0) rows[i] = ld4bf(q); q += D; asm volatile("" : "+v"(q)); }
    }
    const size_t grow0 = SMP ? (size_t)TP + 8 * run : (size_t)run * 8;
#pragma unroll
    for (int o = 0; o < NOUT; ++o) { f32x4 acc = rows[W - 1 + o];
#pragma unroll
        for (int d = 1; d < W; ++d) acc += rows[W - 1 + o - d];
        float cnt = (float)W; if (!SMP) { const int t = (run & 255) * 8 + o; cnt = (float)((t + 1) < W ? (t + 1) : W); }
        const f32x4 y = acc / cnt - rows[W - 1 + o];
        v2u ov; ov.x = cvt_pk_bf16(y[0], y[1]); ov.y = cvt_pk_bf16(y[2], y[3]); *(v2u*)(POOLED + (grow0 + o) * D + col) = ov; }
}

__global__ void __launch_bounds__(NTHR, 2) fwd(Args args) {
    extern __shared__ __attribute__((aligned(16))) unsigned char lds_raw[];
    Frame F;
    F.lds = (LAS unsigned char*)lds_raw; F.ws = args.ws; F.out = args.out;
    F.wave = __builtin_amdgcn_readfirstlane(threadIdx.x >> 6);
    F.G = gridDim.x; F.gw = blockIdx.x * NWAVES + F.wave; F.ngw = F.G * NWAVES;
    volatile LAS unsigned* MISC = (volatile LAS unsigned*)(F.lds + MISC_OFF);
    if (threadIdx.x < 64) MISC[threadIdx.x] = 0u;
    __syncthreads();
    unsigned* ctl = (unsigned*)(args.ws + WS_CTL);
    XcdBarrier bar; bar.bar = ctl + CW_BAR; bar.x = 0; bar.st = nullptr;
#if !MK_SPLIT
    bar = xcd_barrier_post(ctl + CW_BAR, MISC + 8);
#define GRID_BAR() do { XcdBarrier b_ = bar; b_.bar = (unsigned*)opq_p((unsigned char*)b_.bar); xcd_barrier(b_, opq_s(F.wave) == 0 && lane_id() == 0); } while (0)
#else
#define GRID_BAR() do {} while (0)
#endif
    const int lo = args.ph_lo, hi = args.ph_hi;
#define IN(k) (lo <= (k) && (k) < hi)
#define BOTH(k) (IN(k) && IN((k) + 1))
#define PHASE_PTRS() unsigned char* ws = opq_p(args.ws); bf16* HN = (bf16*)(ws + WS_HN); bf16* MEMN = (bf16*)(ws + WS_MEMN); float* X = (float*)opq_p((unsigned char*)args.out) + O_Y; \
    float* Mb = (float*)(ws + WS_M); bf16* Qb = (bf16*)(ws + WS_Q); bf16* AO = (bf16*)(ws + WS_AO); bf16* Hb = (bf16*)(ws + WS_H); float* U = (float*)(ws + WS_U); \
    (void)HN; (void)MEMN; (void)X; (void)Mb; (void)Qb; (void)AO; (void)Hb; (void)U;

    for (int rep_ = 0; rep_ < PROBE_P0; ++rep_) if (IN(0)) { PHASE_PTRS();
        int it = 0;
        for (int l = 0; l < 2; ++l) it = tr_matrix(F, as_global(args.in[17]) + (size_t)l * D * 4096, D, 4096, 4096, (bf16*)(ws + WS_WXKV) + (size_t)l * 4096 * D, D, it);
        it = tr_matrix(F, as_global(args.in[7]), D, NPROJ, NPROJ, (bf16*)(ws + WS_WINA), D, it, as_global(args.in[19]));
        it = tr_matrix(F, as_global(args.in[10]), D, D, D, (bf16*)(ws + WS_WOUTA), D, it);
        it = tr_matrix(F, as_global(args.in[11]), D, D, D, (bf16*)(ws + WS_WINB), D, it, as_global(args.in[19]) + D);
        for (int l = 0; l < 2; ++l) {
            const float* wq_ = as_global(args.in[16]) + (size_t)l * D * D; const float* nx = as_global(args.in[21]) + l * D; bf16* dq = (bf16*)(ws + WS_WXQN) + (size_t)l * D * D;
            for (size_t i = ((size_t)blockIdx.x * NTHR + F.wave * 64 + lane_id()) * 4; i < (size_t)D * D; i += (size_t)F.G * NTHR * 4) {
                const f32x4 v = *(const f32x4*)(wq_ + i) * nx[i >> 11]; v2u o; o.x = cvt_pk_bf16(v[0], v[1]); o.y = cvt_pk_bf16(v[2], v[3]); *(v2u*)(dq + i) = o; } }
        {   const float* pw = as_global(args.in[12]); const float* psc = as_global(args.in[13]); bf16* wps = (bf16*)(ws + WS_WPOOL);
            for (size_t i = ((size_t)blockIdx.x * NTHR + F.wave * 64 + lane_id()) * 4; i < (size_t)4 * 512 * 512; i += (size_t)F.G * NTHR * 4) {
                const f32x4 v = *(const f32x4*)(pw + i) * *(const f32x4*)(psc + (i >> 18) * 512 + (i & 511)); v2u o; o.x = cvt_pk_bf16(v[0], v[1]); o.y = cvt_pk_bf16(v[2], v[3]); *(v2u*)(wps + i) = o; } }
        it = tr_matrix(F, as_global(args.in[14]), D, D, D, (bf16*)(ws + WS_WOUTB), D, it);
        for (int l = 0; l < 2; ++l) {
            it = tr_matrix(F, as_global(args.in[16]) + (size_t)l * D * D, D, D, D, (bf16*)(ws + WS_WXQ) + (size_t)l * D * D, D, it, as_global(args.in[21]) + l * D);
            it = tr_matrix(F, as_global(args.in[18]) + (size_t)l * D * D, D, D, D, (bf16*)(ws + WS_WXO) + (size_t)l * D * D, D, it);
            it = tr_matrix(F, as_global(args.in[25]) + (size_t)l * D * FF, D, FF, FF, (bf16*)(ws + WS_WUP) + (size_t)l * D * FF, D, it, as_global(args.in[23]) + l * D);

        }
        for (int row = F.gw; row < MT; row += F.ngw) {
            const float* xr = row < TP ? as_global(args.in[0]) + (size_t)row * D : as_global(args.in[1]) + (size_t)(row - TP) * D;
            {   const int lane = lane_id(); f32x4 v[8]; float ss = 0.f; bf16* xb = (bf16*)(ws + WS_XB) + (size_t)row * D;
#pragma unroll
                for (int j = 0; j < 8; ++j) { v[j] = *(const f32x4*)(xr + 4 * lane + 256 * j); ss += (v[j][0] * v[j][0] + v[j][1] * v[j][1]) + (v[j][2] * v[j][2] + v[j][3] * v[j][3]);
                    v2u o; o.x = cvt_pk_bf16(v[j][0], v[j][1]); o.y = cvt_pk_bf16(v[j][2], v[j][3]); *(v2u*)(xb + 4 * lane + 256 * j) = o; }
                const float r = 1.0f / sqrtf(wave_sum(ss) * (1.0f / D) + EPS); if (lane == 0) ((float*)(ws + WS_RS))[row] = r; }
        }
        for (int r2 = F.gw; r2 < 2048; r2 += F.ngw) { const int l = r2 >> 10, row = r2 & 1023;
            norm_row(as_global(args.in[6]) + (size_t)row * D, as_global(args.in[15]) + (size_t)l * D, MEMN + ((size_t)l * 1024 + row) * D, nullptr, lane_id()); }
        if (BOTH(0) && rep_ == PROBE_P0 - 1) GRID_BAR();
    }
    for (int rep_ = 0; rep_ < PROBE_G1; ++rep_) if (IN(1)) { PHASE_PTRS();
        pg8::SchedP1 S{(const char*)(ws + WS_XB), (const char*)(ws + WS_WINA), (char*)(ws + WS_QS), (char*)(ws + WS_FL), (char*)(ws + WS_VI), (char*)(ws + WS_GS), (const char*)MEMN, (const char*)(ws + WS_WXKV), (char*)(as_global(args.out) + O_KP), (char*)(as_global(args.out) + O_VP), (char*)(ws + WS_KPB), (char*)(ws + WS_VPB), F.G, (int)blockIdx.x};
        pg8::EpiP1 E{(const float*)(ws + WS_RS)};
        pg8::gemm_phase<pg8::EpiP1, pg8::SchedP1>(F.lds, F.wave, D, D, D, S, E);
        if (BOTH(1) && rep_ == PROBE_G1 - 1) GRID_BAR();
    }
    if (IN(2)) { PHASE_PTRS();
        {   const bf16* QSp = (const bf16*)(ws + WS_QS); const bf16* FLp = (const bf16*)(ws + WS_FL); const bf16* VIp = (const bf16*)(ws + WS_VI); const bf16* GSp = (const bf16*)(ws + WS_GS);
            const int lane = lane_id(); int u = F.gw; PrepIn cur, nxt;
            if (u < NCHUNK * HH) prep_load(cur, QSp, FLp, VIp, GSp, u >> 4, u & 15, lane);
#pragma unroll 1
            while (u < NCHUNK * HH) { const int un = u + F.ngw;
                if (un < NCHUNK * HH) prep_load(nxt, QSp, FLp, VIp, GSp, un >> 4, un & 15, lane);
                prep_compute(cur, as_global(args.in[8]), ws + WS_REC, u >> 4, u & 15, lane);
                cur = nxt; u = un; }
        }
        {   const int wl = blockIdx.x >= 128 ? 1 : 0;
            pg8::SchedWK S{(const char*)(ws + WS_KPB + (size_t)wl * 1024 * D * 2), (const char*)(ws + WS_WXQN + (size_t)wl * D * D * 2), (char*)(ws + (wl ? WS_WKT1 : WS_WKT)), F.G, (int)blockIdx.x, wl * 128}; pg8::EpiBf16<0> E{nullptr};
            pg8::gemm_phase<pg8::EpiBf16<0>, pg8::SchedWK, true>(F.lds, F.wave, D, D, 512, S, E); }
        if (BOTH(2)) GRID_BAR();
    }
    if (IN(3)) { PHASE_PTRS();
        const int lane = lane_id(), w = opq_s(F.wave);
        for (int u = blockIdx.x; u < 256; u += F.G) { const int seg = u & 3, bh = u >> 2;
            if (seg < 3) gla_pass_a(F.lds, ws + WS_REC, (float*)(ws + WS_SEND), (float*)(ws + WS_DSEG), bh >> 4, bh & 15, seg, w, lane); }
        {   pg8::SchedWP S{(const char*)(ws + WS_WOUTB), (const char*)(ws + WS_WPOOL), (char*)(ws + WS_MIXED), F.G, (int)blockIdx.x}; pg8::EpiBf16<0> E{nullptr};
            pg8::gemm_phase<pg8::EpiBf16<0>, pg8::SchedWP, true>(F.lds, F.wave, D, 512, 512, S, E); }
        for (int su = blockIdx.x; su < DB * HH; su += F.G) { const int b = su >> 4, h = su & 15;
            gla_sample(F.lds, ws + WS_REC, (const bf16*)(ws + WS_GS), as_global(args.in[2]) + (size_t)su * 16384, as_global(args.out) + O_SHS + (size_t)su * 16384, as_global(args.in[9]), (bf16*)(ws + WS_OG), b, h, w, lane); }
        if (BOTH(3)) GRID_BAR();
    }
    if (IN(4)) { PHASE_PTRS();
        const int lane = lane_id(), w = opq_s(F.wave);
        for (int u = blockIdx.x; u < 256; u += F.G) { const int seg = u & 3, bh = u >> 2;
            gla_pass_b(F.lds, ws + WS_REC, (const bf16*)(ws + WS_GS), (const float*)(ws + WS_SEND), (const float*)(ws + WS_DSEG), as_global(args.in[9]), (bf16*)(ws + WS_OG), as_global(args.out) + O_SHP + (size_t)bh * 16384, bh >> 4, bh & 15, seg, w, lane); }
        if (BOTH(4)) GRID_BAR();
    }
#define SCHED_G(Ap, lda_, Bp, ldb_, Cp, ldc_, nN_, csz_, gsh_, gkb_) pg8::SchedG{(const char*)(Ap), (const char*)(Bp), (char*)(Cp), lda_, ldb_, ldc_, 36, nN_, csz_, F.G, (int)blockIdx.x, gsh_, gkb_}
    if (IN(5)) { PHASE_PTRS();
        pg8::SchedGS S{(const char*)(ws + WS_OG), (const char*)(ws + WS_WOUTA), (char*)Mb, (char*)(ws + WS_SLAB), D, D, D, 2, F.G, (int)blockIdx.x, 2}; pg8::EpiBf16<0> E{nullptr};
        pg8::gemm_phase<pg8::EpiBf16<0>, pg8::SchedGS, false, true>(F.lds, F.wave, D, D, D, S, E);
        if (BOTH(5)) GRID_BAR();
    }
#pragma unroll
    for (int l = 0; l < 2; ++l) {
        const int base = 6 + 12 * l;
        if (l == 1) {
            if (IN(14)) { PHASE_PTRS();
                pg8::SchedGS S{(const char*)(ws + WS_XB), (const char*)(ws + WS_WINB), (char*)U, (char*)(ws + WS_SLAB), D, D, D, 2, F.G, (int)blockIdx.x, 2}; pg8::EpiBf16<0> E{(const float*)(ws + WS_RS)};
                pg8::gemm_phase<pg8::EpiBf16<0>, pg8::SchedGS, false, true>(F.lds, F.wave, D, D, D, S, E);
                if (BOTH(14)) GRID_BAR();
            }
            if (IN(15)) { PHASE_PTRS();
                bf16* POOLED = (bf16*)(ws + WS_POOLED); const bf16* SL = (const bf16*)(ws + WS_SLAB); const bf16* Ub = (const bf16*)U; const int lane = lane_id();
                const bool deal = F.ngw == 2048; const int gwp = F.gw; const int nun = deal ? (gwp < 1024 ? 4 : 5) : (gwp < 1152 * 8 ? (1152 * 8 - gwp + F.ngw - 1) / F.ngw : 0);
                for (int k = 0; k < nun; ++k) { const int u = deal ? (gwp < 1024 ? (k == 0 ? 8192 + gwp : 3 * gwp + k - 1) : 3072 + 5 * (gwp - 1024) + k) : gwp + k * F.ngw; const int run = u >> 3, j = u & 7;
                    if (run < 1024) { switch (j >> 1) { case 0: pool_unit<2, false>(Ub, SL, as_global(args.in[3]), POOLED, run, j, lane); break; case 1: pool_unit<4, false>(Ub, SL, as_global(args.in[3]), POOLED, run, j, lane); break;
                                                       case 2: pool_unit<8, false>(Ub, SL, as_global(args.in[3]), POOLED, run, j, lane); break; default: pool_unit<16, false>(Ub, SL, as_global(args.in[3]), POOLED, run, j, lane); break; } }
                    else { switch (j >> 1) { case 0: pool_unit<2, true>(Ub, SL, as_global(args.in[3]), POOLED, run - 1024, j, lane); break; case 1: pool_unit<4, true>(Ub, SL, as_global(args.in[3]), POOLED, run - 1024, j, lane); break;
                                             case 2: pool_unit<8, true>(Ub, SL, as_global(args.in[3]), POOLED, run - 1024, j, lane); break; default: pool_unit<16, true>(Ub, SL, as_global(args.in[3]), POOLED, run - 1024, j, lane); break; } } }
                for (int rr = F.gw; rr < (NB + DB) * 15; rr += F.ngw) {
                    if (rr < NB * 15) { const int b = rr / 15, i = rr % 15; const bf16* src = Ub + (size_t)(b * SEQ + SEQ - 15 + i) * D; float* dst = as_global(args.out) + O_SPP + (size_t)rr * D;
#pragma unroll
                        for (int j = 0; j < 8; ++j) *(f32x4*)(dst + 4 * lane + 256 * j) = ld4bf((const GAS bf16*)(unsigned long long)(src + 4 * lane + 256 * j)); }
                    else { const int q = rr - NB * 15, b = q / 15, i = q % 15; float* dst = as_global(args.out) + O_SPS + (size_t)q * D;
                        if (i < 7) { const float* src = as_global(args.in[3]) + (size_t)(b * 15 + 8 + i) * D;
#pragma unroll
                            for (int j = 0; j < 8; ++j) *(f32x4*)(dst + 4 * lane + 256 * j) = *(const f32x4*)(src + 4 * lane + 256 * j); }
                        else { const bf16* sr = SL + (size_t)(8 * b + (i - 7)) * D + 4 * lane;
#pragma unroll
                            for (int j = 0; j < 8; ++j) { f32x4 a = ld4bf((const GAS bf16*)(unsigned long long)(sr + 256 * j));
#pragma unroll
                                for (int ks = 1; ks < 8; ++ks) a += ld4bf((const GAS bf16*)(unsigned long long)(sr + (size_t)ks * TS * D + 256 * j));
                                *(f32x4*)(dst + 4 * lane + 256 * j) = a; } } }
                }
                if (BOTH(15)) GRID_BAR();
            }
            if (IN(17)) { PHASE_PTRS();
                pg8::SchedGS S{(const char*)(ws + WS_POOLED), (const char*)(ws + WS_MIXED), (char*)Mb, (char*)(ws + WS_SLAB), D, D, D, 2, F.G, (int)blockIdx.x, 2}; pg8::EpiBf16<0> E{nullptr};
                pg8::gemm_phase<pg8::EpiBf16<0>, pg8::SchedGS, false, true>(F.lds, F.wave, D, D, D, S, E);
                if (BOTH(17)) GRID_BAR();
            }
        }
        if (IN(base + 0)) { PHASE_PTRS(); t_phase(F, (const bf16*)Mb, (const float*)(ws + WS_SLAB), (bf16*)(ws + WS_XB), nullptr, as_global(args.in[20]) + l * D, (float*)(ws + WS_RS), l == 0 ? as_global(args.in[0]) : nullptr, l == 0 ? as_global(args.in[1]) : nullptr); if (BOTH(base + 0)) GRID_BAR(); }
        if (IN(base + 1)) { PHASE_PTRS();
            LAS unsigned char* xl = F.lds + RING_BYTES;
            {   pg8::SchedS S{(const char*)(ws + WS_XB), (const char*)(ws + (l ? WS_WKT1 : WS_WKT)), (char*)(ws + WS_P), F.G, (int)blockIdx.x}; pg8::EpiSoftmax E{xl + 5120, (const float*)(ws + WS_RS)};
                pg8::gemm_phase<pg8::EpiSoftmax, pg8::SchedS>(F.lds, F.wave, D, D, D, S, E); }
            {   pg8::SchedXQS S{(const char*)(ws + WS_XB), (const char*)(ws + WS_WXQ + (size_t)l * D * D * 2), (char*)(ws + WS_SLAB), F.G, (int)blockIdx.x}; pg8::EpiBf16<0> E{(const float*)(ws + WS_RS)};
                pg8::gemm_phase<pg8::EpiBf16<0>, pg8::SchedXQS, false, true>(F.lds, F.wave, D, D, D, S, E); }
            {   pg8::SchedAtt1V S{nullptr, nullptr, nullptr, (const char*)(ws + WS_WXO + (size_t)l * D * D * 2), (const char*)(ws + WS_VPB + (size_t)l * 1024 * D * 2), (char*)(ws + WS_VWT), F.G, (int)blockIdx.x, 1}; pg8::EpiBf16<0> E{nullptr};
                pg8::gemm_phase<pg8::EpiBf16<0>, pg8::SchedAtt1V, true>(F.lds, F.wave, D, D, 512, S, E); }
            if (BOTH(base + 1)) GRID_BAR();
        }
        for (int rep_ = 0; rep_ < PROBE_ATT; ++rep_) if (IN(base + 2)) { PHASE_PTRS();
            LAS unsigned char* xl = F.lds + RING_BYTES;
            for (int su = blockIdx.x; su < DB * MH; su += F.G)
                attn_sample_block(F, (const float*)(ws + WS_SLAB), as_global(args.in[4]) + (size_t)l * DB * NMEM * D, as_global(args.in[5]) + (size_t)l * DB * NMEM * D, AO, su >> 2, su & 3, xl);
            if (BOTH(base + 2) && rep_ == PROBE_ATT - 1) GRID_BAR();
        }
        if (IN(base + 3)) { PHASE_PTRS();
            pg8::SchedXO S{(const char*)(ws + WS_P), (const char*)(ws + WS_VWT), (char*)Mb, (const char*)AO, (const char*)(ws + WS_WXO + (size_t)l * D * D * 2), (char*)(ws + WS_SLAB), F.G, (int)blockIdx.x}; pg8::EpiBf16<0> E{nullptr};
            pg8::gemm_phase<pg8::EpiBf16<0>, pg8::SchedXO, false, true, true>(F.lds, F.wave, 1024, 1024, D, S, E);
            if (BOTH(base + 3)) GRID_BAR();
        }
        if (IN(base + 4)) { PHASE_PTRS(); t_phase(F, (const bf16*)Mb, (const float*)(ws + WS_SLAB), (bf16*)(ws + WS_XB), nullptr, as_global(args.in[22]) + l * D, (float*)(ws + WS_RS)); if (BOTH(base + 4)) GRID_BAR(); }
        if (IN(base + 5)) { PHASE_PTRS();
            pg8::SchedG S = SCHED_G(ws + WS_XB, D, ws + WS_WUP + (size_t)l * D * FF * 2, D, Hb, FF, 32, 2, 31, 0); pg8::EpiBf16<1> E{(const float*)(ws + WS_RS)};
            pg8::gemm_phase<pg8::EpiBf16<1>, pg8::SchedG>(F.lds, F.wave, D, D, D, S, E);
            if (blockIdx.x >= 128) {
                Frame F2 = F; F2.gw = ((int)blockIdx.x - 128) * NWAVES + F.wave; F2.ngw = 128 * NWAVES;
                (void)tr_matrix(F2, as_global(args.in[26]) + (size_t)l * D * FF, FF, D, D, (bf16*)(ws + WS_WDOWN) + (size_t)l * D * FF, FF, 0); }
            if (BOTH(base + 5)) GRID_BAR();
        }
        if (IN(base + 6)) { PHASE_PTRS();
            pg8::SchedGS S{(const char*)Hb, (const char*)(ws + WS_WDOWN + (size_t)l * D * FF * 2), (char*)Mb, (char*)(ws + WS_SLAB), FF, FF, FF, 2, F.G, (int)blockIdx.x, 2}; pg8::EpiBf16<0> E{nullptr};
            pg8::gemm_phase<pg8::EpiBf16<0>, pg8::SchedGS, false, true>(F.lds, F.wave, FF, FF, FF, S, E);
            if (BOTH(base + 6)) GRID_BAR();
        }
        if (IN(base + 7)) { PHASE_PTRS(); t_phase(F, (const bf16*)Mb, (const float*)(ws + WS_SLAB), (bf16*)(ws + WS_XB), l == 1 ? X : nullptr, as_global(args.in[24]) + l * D, l == 0 ? (float*)(ws + WS_RS) : nullptr); if (BOTH(base + 7)) GRID_BAR(); }
    }
#if MK_LAST_PHASE < 25
    {   const size_t i0 = (size_t)blockIdx.x * NTHR + F.wave * 64 + lane_id(), st = (size_t)F.G * NTHR;
        if (MK_LAST_PHASE < 3) { for (size_t i = i0; i < O_SPP - O_SHP; i += st) args.out[O_SHP + i] = 0.f; for (size_t i = i0; i < O_SPS - O_SHS; i += st) args.out[O_SHS + i] = 0.f; }
        if (MK_LAST_PHASE < 15) { for (size_t i = i0; i < O_KP - O_SPP; i += st) args.out[O_SPP + i] = 0.f; for (size_t i = i0; i < O_END - O_SPS; i += st) args.out[O_SPS + i] = 0.f; }
    }
#endif
#undef IN
#undef BOTH
}

extern "C" void kernel_launch(void* const* d_in, const int* in_sizes, int n_in, void* d_out, int out_size, void* d_ws, size_t ws_size, hipStream_t stream) {
    static int grid = 0;
    if (grid == 0) {
        if (n_in != 27 || (size_t)out_size != O_END || ws_size < WS_END) { fprintf(stderr, "kernel_launch: unexpected shapes: n_in %d out %d ws %zu\n", n_in, out_size, ws_size); grid = -1; return; }
        int dev = 0, cus = 0, per_cu = 0;
        if (hipGetDevice(&dev) != hipSuccess || hipDeviceGetAttribute(&cus, hipDeviceAttributeMultiprocessorCount, dev) != hipSuccess) { grid = -1; return; }
        if (hipFuncSetAttribute((const void*)fwd, hipFuncAttributeMaxDynamicSharedMemorySize, LDS_BYTES) != hipSuccess) { fprintf(stderr, "kernel_launch: hipFuncSetAttribute failed\n"); grid = -1; return; }
        if (hipOccupancyMaxActiveBlocksPerMultiprocessor(&per_cu, (const void*)fwd, NTHR, LDS_BYTES) != hipSuccess || per_cu < 1) fprintf(stderr, "kernel_launch: occupancy query reports %d\n", per_cu);
        (void)hipGetLastError();
        grid = cus;
    }
    if (grid < 0) return;
    (void)hipMemsetAsync((char*)d_ws + WS_CTL, 0, CTL_ZERO_BYTES, stream);
    Args a{};
    for (int i = 0; i < 27; ++i) a.in[i] = (const float*)d_in[i];
    a.out = (float*)d_out; a.ws = (unsigned char*)d_ws;
    const int last = MK_LAST_PHASE + 1;
#if MK_SPLIT
    for (int p = 0; p < last; ++p) { a.ph_lo = p; a.ph_hi = p + 1; hipLaunchKernelGGL(fwd, dim3(grid), dim3(NTHR), LDS_BYTES, stream, a); }
#else
    a.ph_lo = 0; a.ph_hi = last;
    hipLaunchKernelGGL(fwd, dim3(grid), dim3(NTHR), LDS_BYTES, stream, a);
#endif
}
```
